# Optimizing an MI355X kernel written in HIP

```python
import math
import jax, jax.numpy as jnp
from jax import lax
import numpy as np

D_MODEL = 1024
BATCH = 4
SEQ = 4096
DEPTH = 2
DEC_BATCH = 2
DEC_SEQ = 8192
PAST_LEN = 128

RET_HEADS = 4
RET_HEAD_DIM = 128
RET_DIM = RET_HEADS * RET_HEAD_DIM
RET_CHUNK = 128
CONV_DIM = D_MODEL // 2
CONV_WIDTH = 31
CONV_PAD = CONV_WIDTH // 2
AB_IN_DIM = 4 * RET_DIM + 2 * CONV_DIM
AB_OUT_DIM = RET_DIM + CONV_DIM
DIFF_HEADS = 8
DIFF_QK_DIM = 64
DIFF_V_DIM = 2 * DIFF_QK_DIM
DIFF_QK_TOTAL = DIFF_HEADS * 2 * DIFF_QK_DIM
DIFF_V_TOTAL = DIFF_HEADS * DIFF_V_DIM
C_IN_DIM = 2 * DIFF_QK_TOTAL + DIFF_V_TOTAL
Q_BLOCK = 128
D_FF = 2816
ROPE_THETA = 10000.0
EPS = 1e-6
N_EVEN = (DEPTH + 1) // 2
N_ODD = DEPTH // 2

kernel_name = 'hybrid_retention_conv_diffattn_encoder'


def lambda_init_for(layer):
    return 0.8 - 0.6 * math.exp(-0.3 * layer)


def rms_norm(x, g):
    xf = x.astype(jnp.float32)
    y = xf * lax.rsqrt(jnp.mean(xf * xf, axis=-1, keepdims=True) + EPS)
    return (y * g.astype(jnp.float32)).astype(x.dtype)


def rope(x):
    s, d = x.shape[1], x.shape[-1]
    half = d // 2
    inv = ROPE_THETA ** (-jnp.arange(half, dtype=jnp.float32) / half)
    ang = jnp.arange(s, dtype=jnp.float32)[:, None] * inv[None, :]
    cos = jnp.cos(ang)[None, :, None, :]
    sin = jnp.sin(ang)[None, :, None, :]
    xf = x.astype(jnp.float32)
    x1, x2 = xf[..., :half], xf[..., half:]
    return jnp.concatenate([x1 * cos - x2 * sin, x2 * cos + x1 * sin], axis=-1).astype(x.dtype)


def swiglu(x, w_in, w_out):
    g, u = jnp.split(x @ w_in, 2, axis=-1)
    return (jax.nn.silu(g) * u) @ w_out


def retention_one_way(q, k, v, log_gamma, strict):
    b, h, s, d = q.shape
    c = RET_CHUNK
    nc = s // c
    qc = q.reshape(b, h, nc, c, d)
    kc = k.reshape(b, h, nc, c, d)
    vc = v.reshape(b, h, nc, c, v.shape[-1])
    idx = jnp.arange(c, dtype=jnp.float32)
    diff = idx[:, None] - idx[None, :]
    mask = diff > 0 if strict else diff >= 0
    dmat = jnp.where(mask[None], jnp.exp(log_gamma[:, None, None] * jnp.maximum(diff, 0.0)[None]), 0.0)
    scores = jnp.einsum('bhnid,bhnjd->bhnij', qc, kc) * dmat[None, :, None].astype(q.dtype)
    intra = jnp.einsum('bhnij,bhnje->bhnie', scores, vc)
    k_decay = jnp.exp(log_gamma[:, None] * (c - 1 - idx)[None]).astype(k.dtype)
    kv = jnp.einsum('bhnjd,bhnje->nbhde', kc * k_decay[None, :, None, :, None], vc)
    chunk_decay = jnp.exp(log_gamma * c).astype(kv.dtype)[None, :, None, None]

    def step(state, kv_n):
        return state * chunk_decay + kv_n, state

    _, prev = lax.scan(step, jnp.zeros(kv.shape[1:], kv.dtype), kv)
    q_decay = jnp.exp(log_gamma[:, None] * (idx + 1)[None]).astype(q.dtype)
    inter = jnp.einsum('bhnid,nbhde->bhnie', qc * q_decay[None, :, None, :, None], prev)
    return (intra + inter).reshape(b, h, s, v.shape[-1])


def ab_mixer(hn, w_in, decay, ret_norm_g, conv_w, conv_b, conv_norm_g, w_out):
    b, s, _ = hn.shape
    q, k, v, g, ca, cg = jnp.split(hn @ w_in, [RET_DIM, 2 * RET_DIM, 3 * RET_DIM, 4 * RET_DIM, 4 * RET_DIM + CONV_DIM], axis=-1)
    q = rope(q.reshape(b, s, RET_HEADS, RET_HEAD_DIM)).transpose(0, 2, 1, 3)
    k = (rope(k.reshape(b, s, RET_HEADS, RET_HEAD_DIM)) * RET_HEAD_DIM ** -0.5).transpose(0, 2, 1, 3)
    v = v.reshape(b, s, RET_HEADS, RET_HEAD_DIM).transpose(0, 2, 1, 3)
    log_gamma = -jnp.exp(decay.astype(jnp.float32))
    fwd = retention_one_way(q, k, v, log_gamma[0], False)
    bwd = jnp.flip(retention_one_way(jnp.flip(q, 2), jnp.flip(k, 2), jnp.flip(v, 2), log_gamma[1], True), 2)
    o = (fwd + bwd).transpose(0, 2, 1, 3)
    o = rms_norm(o, ret_norm_g.reshape(RET_HEADS, RET_HEAD_DIM)).reshape(b, s, RET_DIM)
    ret_out = jax.nn.silu(g) * o
    u = ca * jax.nn.sigmoid(cg)
    u = lax.conv_general_dilated(u, conv_w[:, None, :], window_strides=(1,), padding=[(CONV_PAD, CONV_PAD)],
                                 dimension_numbers=('NWC', 'WIO', 'NWC'), feature_group_count=CONV_DIM) + conv_b
    u = jax.nn.silu(rms_norm(u, conv_norm_g))
    return jnp.concatenate([ret_out, u], axis=-1) @ w_out


def diff_attn_mixer(hn, w_in, q_norm_g, k_norm_g, lam, subln_g, w_out, lambda_init):
    b, s, _ = hn.shape
    q, k, v = jnp.split(hn @ w_in, [DIFF_QK_TOTAL, 2 * DIFF_QK_TOTAL], axis=-1)
    q = rope(rms_norm(q.reshape(b, s, 2 * DIFF_HEADS, DIFF_QK_DIM), q_norm_g)) * DIFF_QK_DIM ** -0.5
    k = rope(rms_norm(k.reshape(b, s, 2 * DIFF_HEADS, DIFF_QK_DIM), k_norm_g))
    q = q.reshape(b, s, DIFF_HEADS, 2, DIFF_QK_DIM)
    k = k.reshape(b, s, DIFF_HEADS, 2, DIFF_QK_DIM)
    v = v.reshape(b, s, DIFF_HEADS, DIFF_V_DIM)
    lf = lam.astype(jnp.float32)
    lam_full = jnp.exp(jnp.sum(lf[0] * lf[1])) - jnp.exp(jnp.sum(lf[2] * lf[3])) + lambda_init
    nq = s // Q_BLOCK
    qb = q.reshape(b, nq, Q_BLOCK, DIFF_HEADS, 2, DIFF_QK_DIM).transpose(1, 0, 2, 3, 4, 5)

    def block(q_blk):
        sc = jnp.einsum('bqhcd,bkhcd->bhcqk', q_blk, k).astype(jnp.float32)
        p = jax.nn.softmax(sc, axis=-1)
        w = (p[:, :, 0] - lam_full * p[:, :, 1]).astype(v.dtype)
        return jnp.einsum('bhqk,bkhe->bqhe', w, v)

    o = lax.map(block, qb)
    o = o.transpose(1, 0, 2, 3, 4).reshape(b, s, DIFF_HEADS, DIFF_V_DIM)
    o = rms_norm(o, subln_g) * (1.0 - lambda_init)
    return o.reshape(b, s, DIFF_V_TOTAL) @ w_out


def trunk(x, norm_g, ffn_w_in, ffn_w_out, ab_w_in, ab_decay, ab_ret_norm_g, ab_conv_w, ab_conv_b,
          ab_conv_norm_g, ab_w_out, c_w_in, c_q_norm_g, c_k_norm_g, c_lambda, c_subln_g, c_w_out):
    for layer in range(DEPTH):
        x = x + 0.5 * swiglu(rms_norm(x, norm_g[layer, 0]), ffn_w_in[layer, 0], ffn_w_out[layer, 0])
        hn = rms_norm(x, norm_g[layer, 1])
        i = layer // 2
        if layer % 2 == 0:
            x = x + ab_mixer(hn, ab_w_in[i], ab_decay[i], ab_ret_norm_g[i], ab_conv_w[i], ab_conv_b[i],
                             ab_conv_norm_g[i], ab_w_out[i])
        else:
            x = x + diff_attn_mixer(hn, c_w_in[i], c_q_norm_g[i], c_k_norm_g[i], c_lambda[i], c_subln_g[i],
                                    c_w_out[i], lambda_init_for(layer))
        x = x + 0.5 * swiglu(rms_norm(x, norm_g[layer, 2]), ffn_w_in[layer, 1], ffn_w_out[layer, 1])
    return x


def setup_inputs(seed: int = 0) -> dict:
    key = jax.random.key(seed)
    ks = jax.random.split(key, 20)
    f32 = jnp.float32
    nrm = lambda k, shape, scale: jax.random.normal(k, shape, f32) * scale
    decay0 = np.log(-np.log(1.0 - 2.0 ** (-5.0 - np.arange(RET_HEADS)))).astype(np.float32)
    return {
        'x_prompt': nrm(ks[0], (BATCH, SEQ, D_MODEL), 1.0),
        'x_sample': nrm(ks[1], (DEC_BATCH, DEC_SEQ, D_MODEL), 1.0),
        'norm_g': 1.0 + nrm(ks[2], (DEPTH, 3, D_MODEL), 0.02),
        'ffn_w_in': nrm(ks[3], (DEPTH, 2, D_MODEL, 2 * D_FF), D_MODEL ** -0.5),
        'ffn_w_out': nrm(ks[4], (DEPTH, 2, D_FF, D_MODEL), D_FF ** -0.5),
        'ab_w_in': nrm(ks[5], (N_EVEN, D_MODEL, AB_IN_DIM), D_MODEL ** -0.5),
        'ab_decay': jnp.asarray(decay0)[None, None, :] + nrm(ks[6], (N_EVEN, 2, RET_HEADS), 0.05),
        'ab_ret_norm_g': 1.0 + nrm(ks[7], (N_EVEN, RET_DIM), 0.02),
        'ab_conv_w': nrm(ks[8], (N_EVEN, CONV_WIDTH, CONV_DIM), CONV_WIDTH ** -0.5),
        'ab_conv_b': nrm(ks[9], (N_EVEN, CONV_DIM), 0.01),
        'ab_conv_norm_g': 1.0 + nrm(ks[10], (N_EVEN, CONV_DIM), 0.02),
        'ab_w_out': nrm(ks[11], (N_EVEN, AB_OUT_DIM, D_MODEL), AB_OUT_DIM ** -0.5),
        'c_w_in': nrm(ks[12], (N_ODD, D_MODEL, C_IN_DIM), D_MODEL ** -0.5),
        'c_q_norm_g': 1.0 + nrm(ks[13], (N_ODD, DIFF_QK_DIM), 0.02),
        'c_k_norm_g': 1.0 + nrm(ks[14], (N_ODD, DIFF_QK_DIM), 0.02),
        'c_lambda': nrm(ks[15], (N_ODD, 4, DIFF_QK_DIM), 0.1),
        'c_subln_g': 1.0 + nrm(ks[16], (N_ODD, DIFF_V_DIM), 0.02),
        'c_w_out': nrm(ks[17], (N_ODD, DIFF_V_TOTAL, D_MODEL), DIFF_V_TOTAL ** -0.5),
    }


def reference(x_prompt, x_sample, norm_g, ffn_w_in, ffn_w_out, ab_w_in, ab_decay, ab_ret_norm_g, ab_conv_w,
              ab_conv_b, ab_conv_norm_g, ab_w_out, c_w_in, c_q_norm_g, c_k_norm_g, c_lambda, c_subln_g, c_w_out):
    y_prompt = trunk(x_prompt, norm_g, ffn_w_in, ffn_w_out, ab_w_in, ab_decay, ab_ret_norm_g, ab_conv_w, ab_conv_b,
                     ab_conv_norm_g, ab_w_out, c_w_in, c_q_norm_g, c_k_norm_g, c_lambda, c_subln_g, c_w_out)
    y_sample = trunk(x_sample, norm_g, ffn_w_in, ffn_w_out, ab_w_in, ab_decay, ab_ret_norm_g, ab_conv_w, ab_conv_b,
                     ab_conv_norm_g, ab_w_out, c_w_in, c_q_norm_g, c_k_norm_g, c_lambda, c_subln_g, c_w_out)
    return (y_prompt, y_sample)
```

```cpp
#include <hip/hip_runtime.h>
#include <hip/hip_cooperative_groups.h>
#include <cstdio>
#include <cstdint>
namespace cg = cooperative_groups;
namespace pg8 {
#define PG8_LAS __attribute__((address_space(3)))
typedef unsigned short bf16_t;
typedef short bf16x8 __attribute__((ext_vector_type(8)));
typedef float f32x4 __attribute__((ext_vector_type(4)));
typedef unsigned u32x4 __attribute__((ext_vector_type(4)));
constexpr int BM = 256, BK = 64, HALF = 128, HTB = HALF * BK * 2  , STAGE_BYTES = 8 * HTB, NXCD = 8, WGM = 8;

__host__ __device__ __forceinline__ int lds_byte(int r, int c) { const int st = (r >> 4) * 2 + (c >> 5), rr = r & 15, cc = c & 31, ob = rr * 64 + cc * 2; return st * 1024 + (ob ^ (((ob >> 9) & 1) << 5)); }
__host__ __device__ __forceinline__ void stage_rc(int b, int& R, int& C) { const int st = b / 1024, sb = b % 1024, swz = sb ^ (((sb >> 9) & 1) << 5); R = (st >> 1) * 16 + swz / 64; C = (st & 1) * 32 + (swz % 64) / 2; }
__host__ __device__ __forceinline__ int perm32(int rho) { const int n = rho >> 4, i = rho & 15; return 8 * (i >> 2) + 4 * n + (i & 3); }

struct Unit { int pm, pn; };
struct Gemm { const bf16_t* A; const bf16_t* Bt; int M, N, K; };

struct StaticOrder {
    int nM, nN, nwg, G, c;
    __host__ __device__ void init(int M, int N, int G_, int c_) { nM = M / BM; nN = N / BM; nwg = nM * nN; G = G_; c = c_; }
    __host__ __device__ bool next(int i, Unit& u) const {
        const long L = (long)i * G + c; if (L >= nwg) return false;
        int wgid = (int)L; { const int q = nwg / NXCD, r = nwg % NXCD, xcd = wgid % NXCD, off = wgid / NXCD; wgid = (xcd < r ? xcd * (q + 1) : r * (q + 1) + (xcd - r) * q) + off; }
        const int nig = WGM * nN, gid = wgid / nig, fm = gid * WGM, gsz = (nM - fm) < WGM ? (nM - fm) : WGM;
        u.pm = fm + ((wgid % nig) % gsz); u.pn = (wgid % nig) / gsz; return true;
    }
    __device__ __forceinline__ void a_ready(const Unit&) const {}
    __device__ __forceinline__ void done(const Unit&) const {}
};

typedef float f32x2cv __attribute__((ext_vector_type(2))); typedef __bf16 bf16x2cv __attribute__((ext_vector_type(2)));
__device__ __forceinline__ unsigned cvt_pk_bf16(float lo, float hi) { f32x2cv v = {lo, hi}; bf16x2cv b = __builtin_convertvector(v, bf16x2cv); return __builtin_bit_cast(unsigned, b); }
typedef float f32x2 __attribute__((ext_vector_type(2)));
template <class Epi, class Sched, bool ALIGN_EPI = false, bool SP2 = false>
__device__ __forceinline__ void gemm_phase(PG8_LAS unsigned char* lds, const Gemm g, const Sched& S, const Epi& E) {
    int tid_ = threadIdx.x; asm volatile("" : "+v"(tid_)); const int tid = tid_, wid = __builtin_amdgcn_readfirstlane(tid >> 6), lane = tid & 63, wr = wid >> 2, wc = wid & 3, fr = lane & 15, fq = lane >> 4;
    const int K = g.K, nt = K / BK;
    unsigned voffA[2], voffB[2];
#pragma unroll
    for (int i = 0; i < 2; ++i) { int R, C; stage_rc(tid * 16 + i * 8192, R, C); const int Rb = Epi::PERM ? ((R & ~31) + perm32(R & 31)) : R;
        voffA[i] = (unsigned)(R * K + C) * 2u; voffB[i] = (unsigned)(Rb * K + C) * 2u; }
    const size_t kstep = (size_t)(BK * 2);
    const size_t hstep = (size_t)HALF * K * 2;
    const size_t tstep = 2 * hstep;
    const unsigned ldsw = (unsigned)wid * 1024u;
    const int aoff = lds_byte(wr * 64 + fr, fq * 8), boff = lds_byte(wc * 32 + fr, fq * 8);
#define PG8_SA(b, h) (((b) * 2 + (h)) * HTB)
#define PG8_SB(b, h) ((4 + (b) * 2 + (h)) * HTB)
#define PG8_STAGE(bufoff, gbase, voff) do { _Pragma("unroll") for (int _i = 0; _i < 2; ++_i) \
        __builtin_amdgcn_global_load_lds((const unsigned*)((const char*)(gbase) + (voff)[_i]), (PG8_LAS unsigned*)(lds + (bufoff) + ldsw + _i * 8192), 16, 0, 0); } while (0)
#define PG8_LDA(dst, b, h) do { _Pragma("unroll") for (int m = 0; m < 4; ++m) _Pragma("unroll") for (int k = 0; k < 2; ++k) dst[m][k] = *(const PG8_LAS bf16x8*)(lds + PG8_SA(b, h) + aoff + m * 2048 + k * 1024); } while (0)
#define PG8_LDB(dst, b, h) do { _Pragma("unroll") for (int n = 0; n < 2; ++n) _Pragma("unroll") for (int k = 0; k < 2; ++k) dst[n][k] = *(const PG8_LAS bf16x8*)(lds + PG8_SB(b, h) + boff + n * 2048 + k * 1024); } while (0)
#define PG8_MMA(ai, bj, At, Bt) do { __builtin_amdgcn_s_setprio(1); _Pragma("unroll") for (int m = 0; m < 4; ++m) _Pragma("unroll") for (int n = 0; n < 2; ++n) _Pragma("unroll") for (int k = 0; k < 2; ++k) \
        acc[ai][bj][m][n] = __builtin_amdgcn_mfma_f32_16x16x32_bf16(Bt[n][k], At[m][k], acc[ai][bj][m][n], 0, 0, 0); __builtin_amdgcn_s_setprio(0); } while (0)
#define PG8_WAIT_V(n) asm volatile("s_waitcnt vmcnt(" #n ")" ::: "memory")
#define PG8_WAIT_L(n) asm volatile("s_waitcnt lgkmcnt(" #n ")" ::: "memory")
#define PG8_BAR __builtin_amdgcn_s_barrier()
#define PG8_SCHED __builtin_amdgcn_sched_barrier(0)
    Unit cur, nxt; int ui = 0;
    if (!S.next(0, cur)) return;
    f32x4 acc[2][2][4][2];
#pragma unroll
    for (int a = 0; a < 2; ++a)
#pragma unroll
        for (int b = 0; b < 2; ++b)
#pragma unroll
            for (int m = 0; m < 4; ++m)
#pragma unroll
                for (int n = 0; n < 2; ++n) acc[a][b][m][n] = (f32x4){0.f, 0.f, 0.f, 0.f};
    bf16x8 At[4][2], B0[2][2], B1[2][2];
    const char* cA = (const char*)g.A + (size_t)cur.pm * tstep; const char* cB = (const char*)g.Bt + (size_t)cur.pn * tstep;
    S.a_ready(cur);
    if constexpr (SP2) {
        PG8_STAGE(PG8_SB(0, 0), cB, voffB); PG8_STAGE(PG8_SB(0, 1), cB + hstep, voffB); PG8_STAGE(PG8_SA(0, 0), cA, voffA); PG8_STAGE(PG8_SA(0, 1), cA + hstep, voffA);
        if (wr == 1) PG8_BAR;
        PG8_WAIT_V(2); PG8_BAR;
        PG8_STAGE(PG8_SB(1, 0), cB + kstep, voffB); PG8_STAGE(PG8_SA(1, 0), cA + kstep, voffA); PG8_STAGE(PG8_SB(1, 1), cB + hstep + kstep, voffB);
        PG8_WAIT_V(6); PG8_BAR;
    } else {
        PG8_STAGE(PG8_SB(0, 0), cB, voffB); PG8_STAGE(PG8_SA(0, 0), cA, voffA); PG8_STAGE(PG8_SB(0, 1), cB + hstep, voffB); PG8_STAGE(PG8_SA(0, 1), cA + hstep, voffA);
        if (wr == 1) PG8_BAR;
        PG8_WAIT_V(4); PG8_BAR;
        PG8_STAGE(PG8_SB(1, 0), cB + kstep, voffB); PG8_STAGE(PG8_SA(1, 0), cA + kstep, voffA); PG8_STAGE(PG8_SB(1, 1), cB + hstep + kstep, voffB);
        PG8_WAIT_V(6); PG8_BAR;
    }
    for (;;) {
        const bool has_next = S.next(ui + 1, nxt);
        const char* nA = has_next ? (const char*)g.A + (size_t)nxt.pm * tstep : cA; const char* nB = has_next ? (const char*)g.Bt + (size_t)nxt.pn * tstep : cB;
        for (int t = 0; t < nt; t += 2) {
            const bool last = (t == nt - 2);
            const char* a1 = cA + (size_t)(t + 1) * kstep;
            const char* a2 = last ? nA : cA + (size_t)(t + 2) * kstep; const char* b2 = last ? nB : cB + (size_t)(t + 2) * kstep;
            const char* a3 = a2 + kstep; const char* b3 = b2 + kstep;
            if (last && has_next) S.a_ready(nxt);
            if constexpr (SP2) {
            PG8_LDB(B0, 0, 0); PG8_LDB(B1, 0, 1); PG8_SCHED; PG8_LDA(At, 0, 0); PG8_STAGE(PG8_SA(1, 1), a1 + hstep, voffA);
            PG8_WAIT_V(8); PG8_WAIT_L(0); PG8_BAR; PG8_MMA(0, 0, At, B0); PG8_MMA(0, 1, At, B1); PG8_BAR; PG8_SCHED;
            PG8_LDA(At, 0, 1); PG8_STAGE(PG8_SB(0, 0), b2, voffB); PG8_STAGE(PG8_SB(0, 1), b2 + hstep, voffB); PG8_STAGE(PG8_SA(0, 0), a2, voffA);
            PG8_WAIT_V(8); PG8_WAIT_L(0); PG8_BAR; PG8_MMA(1, 0, At, B0); PG8_MMA(1, 1, At, B1); PG8_BAR; PG8_SCHED;
            PG8_LDB(B0, 1, 0); PG8_LDB(B1, 1, 1); PG8_SCHED; PG8_LDA(At, 1, 0); PG8_STAGE(PG8_SA(0, 1), a2 + hstep, voffA);
            PG8_WAIT_V(8); PG8_WAIT_L(0); PG8_BAR; PG8_MMA(0, 0, At, B0); PG8_MMA(0, 1, At, B1); PG8_BAR; PG8_SCHED;
            PG8_LDA(At, 1, 1); PG8_STAGE(PG8_SB(1, 0), b3, voffB); PG8_STAGE(PG8_SB(1, 1), b3 + hstep, voffB); PG8_STAGE(PG8_SA(1, 0), a3, voffA);
            PG8_WAIT_V(8); PG8_WAIT_L(0); PG8_BAR; PG8_MMA(1, 0, At, B0); PG8_MMA(1, 1, At, B1); PG8_BAR; PG8_SCHED;
            } else {
            PG8_LDB(B0, 0, 0); PG8_SCHED; PG8_LDA(At, 0, 0); PG8_STAGE(PG8_SA(1, 1), a1 + hstep, voffA);
            PG8_WAIT_L(8); PG8_BAR; PG8_WAIT_L(0); PG8_MMA(0, 0, At, B0); PG8_BAR; PG8_SCHED;
            PG8_LDB(B1, 0, 1); PG8_STAGE(PG8_SB(0, 0), b2, voffB);
            PG8_BAR; PG8_WAIT_L(0); PG8_MMA(0, 1, At, B1); PG8_BAR;
            PG8_LDA(At, 0, 1); PG8_STAGE(PG8_SA(0, 0), a2, voffA);
            PG8_BAR; PG8_WAIT_L(0); PG8_MMA(1, 0, At, B0); PG8_BAR; PG8_SCHED;
            PG8_STAGE(PG8_SB(0, 1), b2 + hstep, voffB);
            PG8_WAIT_V(6); PG8_BAR; PG8_MMA(1, 1, At, B1); PG8_BAR;
            PG8_LDB(B0, 1, 0); PG8_SCHED; PG8_LDA(At, 1, 0); PG8_STAGE(PG8_SA(0, 1), a2 + hstep, voffA);
            PG8_WAIT_L(8); PG8_BAR; PG8_WAIT_L(0); PG8_MMA(0, 0, At, B0); PG8_BAR; PG8_SCHED;
            PG8_LDB(B1, 1, 1); PG8_STAGE(PG8_SB(1, 0), b3, voffB);
            PG8_BAR; PG8_WAIT_L(0); PG8_MMA(0, 1, At, B1); PG8_BAR;
            PG8_LDA(At, 1, 1); PG8_STAGE(PG8_SA(1, 0), a3, voffA);
            PG8_BAR; PG8_WAIT_L(0); PG8_MMA(1, 0, At, B0); PG8_BAR; PG8_SCHED;
            PG8_STAGE(PG8_SB(1, 1), b3 + hstep, voffB);
            PG8_WAIT_V(6); PG8_BAR; PG8_MMA(1, 1, At, B1); PG8_BAR;
            }
        }
        if constexpr (ALIGN_EPI) { if (wr == 0) PG8_BAR; }
        if constexpr (!Epi::AFTER_DRAIN) { E(acc, cur, wr, wc, fr, fq); S.done(cur); }
        if (!has_next) break;
#pragma unroll
        for (int a = 0; a < 2; ++a)
#pragma unroll
            for (int b = 0; b < 2; ++b)
#pragma unroll
                for (int m = 0; m < 4; ++m)
#pragma unroll
                    for (int n = 0; n < 2; ++n) acc[a][b][m][n] = (f32x4){0.f, 0.f, 0.f, 0.f};
        cur = nxt; cA = nA; cB = nB; ++ui;
        if constexpr (ALIGN_EPI) { if (wr == 1) PG8_BAR; }
    }
    PG8_WAIT_V(0);
    if constexpr (!ALIGN_EPI) { if (wr == 0) PG8_BAR; }
    PG8_BAR;
    if constexpr (Epi::AFTER_DRAIN) { E.fused(acc, cur, wr, wc, fr, fq, lds, wid, lane); S.done(cur); }
#undef PG8_SA
#undef PG8_SB
#undef PG8_STAGE
#undef PG8_LDA
#undef PG8_LDB
#undef PG8_MMA
#undef PG8_WAIT_V
#undef PG8_WAIT_L
#undef PG8_BAR
#undef PG8_SCHED
}
}

namespace mk {
using pg8::bf16_t; using pg8::bf16x8; using pg8::f32x4; using pg8::u32x4; using pg8::Unit; using pg8::cvt_pk_bf16;
#define LAS __attribute__((address_space(3)))
typedef LAS unsigned char* ldsp;
typedef float f32x16 __attribute__((ext_vector_type(16)));
typedef short v4i16 __attribute__((ext_vector_type(4)));

constexpr int M = 32768, D = 1024, DFF = 2816, NPROMPT = 16384;
constexpr float EPS = 1e-6f, LOG2E = 1.4426950408889634f;
constexpr float LINIT1 = 0.35550906759096924f;
constexpr int LDS_BYTES = 147456 + 64, LDS_MISC = 147456;

constexpr size_t MiB = 1u << 20;
constexpr size_t WS_TAB0 = 0, WS_TAB1 = 4 * MiB;
constexpr size_t WS_SS = 6 * MiB;
constexpr size_t WS_CTL = 7 * MiB + 768 * 1024, CTL_BYTES = 16384;
constexpr size_t WS_W = 8 * MiB;
constexpr size_t W_FFI = (size_t)5632 * 1024 * 2, W_FFO = (size_t)1024 * 2816 * 2, W_IN = (size_t)3072 * 1024 * 2, W_OUT = (size_t)1024 * 1024 * 2;
constexpr size_t WS_FFI = WS_W, WS_FFO = WS_FFI + 4 * W_FFI, WS_ABI = WS_FFO + 4 * W_FFO, WS_CI = WS_ABI + W_IN, WS_ABO = WS_CI + W_IN, WS_CO = WS_ABO + W_OUT;
constexpr size_t WS_XN = 90 * MiB;
constexpr size_t WS_BIG = 154 * MiB;
constexpr size_t WS_H = WS_BIG;
constexpr size_t WS_QU = WS_BIG, WS_K0 = WS_BIG + 64 * MiB, WS_V0 = WS_BIG + 96 * MiB, WS_SG = WS_BIG + 128 * MiB, WS_U = WS_BIG + 160 * MiB;
constexpr size_t WS_Q1 = WS_BIG, WS_K1 = WS_BIG + 64 * MiB, WS_V1 = WS_BIG + 128 * MiB;
constexpr size_t WS_END = 346 * MiB;
static_assert(WS_CO + W_OUT <= WS_XN, "weights fit");
static_assert(WS_H + (size_t)M * DFF * 2 <= WS_END, "h fits");

#define XB_TMO      128
#define XB_XCNT(j)  (256  + 64 * (j))
#define XB_XSUB(j)  (1280 + 64 * (j))
#define XB_XGEN(j)  (2304 + 64 * (j))
#define XB_TOP      3328
#define XB_TOPGEN   3392
#define XCD_BAR_WORDS 3456
#define XB_SPIN_CAP (1u << 18)

__device__ __forceinline__ unsigned xb_ld(unsigned* p)              { return __hip_atomic_load(p, __ATOMIC_RELAXED, __HIP_MEMORY_SCOPE_AGENT); }
__device__ __forceinline__ unsigned xb_add(unsigned* p, unsigned v) { return __hip_atomic_fetch_add(p, v, __ATOMIC_RELAXED, __HIP_MEMORY_SCOPE_AGENT); }
__device__ __forceinline__ unsigned xb_xcc_id() { return (unsigned)__builtin_amdgcn_s_getreg((3 << 11) | 20) & 0xFu; }
#define XB_SPIN(cond, bar) do { unsigned _sp = 0; while (cond) { __builtin_amdgcn_s_sleep(1); \
    if ((++_sp & 255u) == 0u) { if (xb_ld(&(bar)[XB_TMO])) break; if (_sp > XB_SPIN_CAP) { atomicAdd(&(bar)[XB_TMO], 1u); break; } } } } while (0)

struct XcdBarrier {
    unsigned* bar; unsigned x;
    volatile LAS unsigned* st;
};

__device__ __forceinline__ XcdBarrier xcd_barrier_post(unsigned* bar, volatile LAS unsigned* st) {
    XcdBarrier b; b.bar = bar; b.x = xb_xcc_id(); b.st = st;
    if (threadIdx.x == 0) (void)xb_add(&bar[XB_XCNT(b.x)], 1u);
    return b;
}
__device__ __forceinline__ void xcd_barrier_complete(unsigned* bar, unsigned x, unsigned& nloc, unsigned& nx) {
    const unsigned G = gridDim.x * gridDim.y * gridDim.z;
    unsigned sum, cnt, mine, sp = 0u;
    for (;;) {
        sum = 0u; cnt = 0u; mine = 0u;
#pragma unroll
        for (unsigned j = 0; j < 16; ++j) { const unsigned c = xb_ld(&bar[XB_XCNT(j)]); sum += c; cnt += (c > 0u) ? 1u : 0u; mine = (j == x) ? c : mine; }
        if (sum == G) break;
        __builtin_amdgcn_s_sleep(1);
        if ((++sp & 255u) == 0u) { if (xb_ld(&bar[XB_TMO])) break; if (sp > XB_SPIN_CAP) { atomicAdd(&bar[XB_TMO], 1u); break; } }
    }
    nloc = mine > 0u ? mine : 1u; nx = cnt > 0u ? cnt : 1u;
}

__device__ __forceinline__ void xcd_barrier(const XcdBarrier& b) {
    asm volatile("s_waitcnt vmcnt(0)" ::: "memory");
    __syncthreads();
    if (threadIdx.x == 0) {
        unsigned* bar = b.bar;
        __builtin_amdgcn_s_waitcnt(0);
        unsigned nloc = b.st[0], nx = b.st[1];
        if (nloc == 0u) { xcd_barrier_complete(bar, b.x, nloc, nx); b.st[0] = nloc; b.st[1] = nx; }
        const unsigned old = xb_add(&bar[XB_XSUB(b.x)], 1u);
        const unsigned gen = old / nloc;
        if (old + 1u == (gen + 1u) * nloc) {
            __builtin_amdgcn_fence(__ATOMIC_RELEASE, "agent");
            asm volatile("s_waitcnt vmcnt(0)" ::: "memory");
            const unsigned og = xb_add(&bar[XB_TOP], 1u);
            const unsigned tg = og / nx;
            if (og + 1u == (tg + 1u) * nx) xb_add(&bar[XB_TOPGEN], 1u);
            else XB_SPIN(xb_ld(&bar[XB_TOPGEN]) == tg, bar);
            __builtin_amdgcn_fence(__ATOMIC_ACQUIRE, "agent");
            xb_add(&bar[XB_XGEN(b.x)], 1u);
            asm volatile("s_waitcnt vmcnt(0)" ::: "memory");
        } else {
            XB_SPIN(xb_ld(&bar[XB_XGEN(b.x)]) == gen, bar);
            __builtin_amdgcn_fence(__ATOMIC_ACQUIRE, "agent");
            asm volatile("s_waitcnt vmcnt(0)" ::: "memory");
        }
    }
    __syncthreads();
}

__device__ __forceinline__ float bf2f(unsigned short b) { return __uint_as_float(((unsigned)b) << 16); }
__device__ __forceinline__ float bflo(unsigned w) { return __uint_as_float(w << 16); }
__device__ __forceinline__ float bfhi(unsigned w) { return __uint_as_float(w & 0xffff0000u); }
__device__ __forceinline__ unsigned short f2bf(float f) { return (unsigned short)(cvt_pk_bf16(f, 0.f) & 0xffffu); }
__device__ __forceinline__ float ssf(unsigned long long v) { return (float)v * (1.f / 1048576.f); }
__device__ __forceinline__ float ex2(float x) { return __builtin_amdgcn_exp2f(x); }
__device__ __forceinline__ float sigmoidf_(float x) { return __builtin_amdgcn_rcpf(1.f + ex2(-x * LOG2E)); }
__device__ __forceinline__ float siluf_(float x) { return x * sigmoidf_(x); }
__device__ __forceinline__ float wave_sum(float v) {
#pragma unroll
    for (int o = 1; o < 64; o <<= 1) v += __shfl_xor(v, o);
    return v;
}
__device__ __forceinline__ float wave_max(float v) {
#pragma unroll
    for (int o = 1; o < 64; o <<= 1) v = fmaxf(v, __shfl_xor(v, o));
    return v;
}
__device__ __forceinline__ float sum32(float v) {
#pragma unroll
    for (int o = 1; o < 32; o <<= 1) v += __shfl_xor(v, o);
    return v;
}
__device__ __forceinline__ int otid() { int t = threadIdx.x; asm volatile("" : "+v"(t)); return t; }
__device__ __forceinline__ int obx() { int b = blockIdx.x; asm volatile("" : "+s"(b)); return b; }
__device__ __forceinline__ int pos_of_row(int row) { return row < NPROMPT ? (row & 4095) : (row & 8191); }
__device__ __forceinline__ int crow(int r, int hi) { return (r & 3) + 8 * (r >> 2) + 4 * hi; }
__device__ __forceinline__ f32x16 mfma32(bf16x8 a, bf16x8 b, f32x16 c) { return __builtin_amdgcn_mfma_f32_32x32x16_bf16(a, b, c, 0, 0, 0); }
__device__ __forceinline__ v4i16 trrd(ldsp p) { return __builtin_amdgcn_ds_read_tr16_b64_v4i16((LAS v4i16*)p); }
__device__ __forceinline__ bf16x8 tr_frag(ldsp p, int off2) { const v4i16 a = trrd(p), b = trrd(p + off2); return (bf16x8){a[0], a[1], a[2], a[3], b[0], b[1], b[2], b[3]}; }
__device__ __forceinline__ bf16x8 pack8(float a, float b, float c, float d, float e, float f, float g, float h) {
    u32x4 w; w.x = cvt_pk_bf16(a, b); w.y = cvt_pk_bf16(c, d); w.z = cvt_pk_bf16(e, f); w.w = cvt_pk_bf16(g, h); return __builtin_bit_cast(bf16x8, w);
}

typedef float f32x2p __attribute__((ext_vector_type(2)));
__device__ __forceinline__ f32x2p swiglu2(f32x2p g, f32x2p u, float kneg, float r2) {
    const f32x2p t = g * kneg;
    f32x2p e; e.x = ex2(t.x); e.y = ex2(t.y);
    const f32x2p d = e + 1.0f;
    f32x2p r; r.x = __builtin_amdgcn_rcpf(d.x); r.y = __builtin_amdgcn_rcpf(d.y);
    return (g * u) * (r * r2);
}
struct EpiSwiglu {
    static constexpr bool PERM = true, AFTER_DRAIN = false; bf16_t* H; const unsigned long long* ss;
    __device__ __forceinline__ void operator()(const f32x4 (&acc)[2][2][4][2], const Unit& u, int wr, int wc, int fr, int fq) const {
        const int row0 = u.pm * 256 + wr * 64 + fr, col0 = u.pn * 128 + wc * 32 + 8 * fq;
#pragma unroll
        for (int ai = 0; ai < 2; ++ai)
#pragma unroll
            for (int m = 0; m < 4; ++m) {
                bf16_t* rp = H + (size_t)(row0 + ai * 128 + m * 16) * DFF + col0;
                const float rstd = __builtin_amdgcn_rsqf(ssf(ss[row0 + ai * 128 + m * 16]) * (1.f / D) + EPS);
                const float kneg = -rstd * LOG2E, r2 = rstd * rstd;
                const f32x4 g0 = acc[ai][0][m][0], g1 = acc[ai][0][m][1], u0 = acc[ai][1][m][0], u1 = acc[ai][1][m][1];
                const f32x2p a = swiglu2((f32x2p){g0[0], g0[1]}, (f32x2p){u0[0], u0[1]}, kneg, r2), b = swiglu2((f32x2p){g0[2], g0[3]}, (f32x2p){u0[2], u0[3]}, kneg, r2);
                const f32x2p c = swiglu2((f32x2p){g1[0], g1[1]}, (f32x2p){u1[0], u1[1]}, kneg, r2), d = swiglu2((f32x2p){g1[2], g1[3]}, (f32x2p){u1[2], u1[3]}, kneg, r2);
                u32x4 w; w.x = cvt_pk_bf16(a.x, a.y); w.y = cvt_pk_bf16(b.x, b.y); w.z = cvt_pk_bf16(c.x, c.y); w.w = cvt_pk_bf16(d.x, d.y);
                *(u32x4*)rp = w;
                asm volatile("" ::: "memory");
            }
    }
};
__device__ __forceinline__ void store8(bf16_t* p, const float (&v)[8]) {
    u32x4 w; w.x = cvt_pk_bf16(v[0], v[1]); w.y = cvt_pk_bf16(v[2], v[3]); w.z = cvt_pk_bf16(v[4], v[5]); w.w = cvt_pk_bf16(v[6], v[7]); *(u32x4*)p = w;
}
template <int MODE> struct EpiResid {
    static constexpr bool PERM = true, AFTER_DRAIN = false; const float* baseA; const float* baseB; float* out; float scale; bf16_t* XB; unsigned long long* ss;
    __device__ __forceinline__ void operator()(const f32x4 (&acc)[2][2][4][2], const Unit& u, int wr, int wc, int fr, int fq) const {
        const int row0 = u.pm * 256 + wr * 64 + fr, col0 = u.pn * 256 + wc * 32 + 8 * fq;
        const float* bp = (u.pm < 64) ? baseA + (size_t)row0 * D : baseB + (size_t)(row0 - NPROMPT) * D;
        float* op = out + (size_t)row0 * D;
        bf16_t* xp = XB + (size_t)row0 * D;
#pragma unroll
        for (int ai = 0; ai < 2; ++ai)
#pragma unroll
            for (int m = 0; m < 4; ++m) {
                const size_t ro = (size_t)(ai * 128 + m * 16) * D + col0;
                float sq = 0.f;
#pragma unroll
                for (int bj = 0; bj < 2; ++bj) {
                    f32x4 b0, b1;
                    if (MODE == 0) { b0 = *(const f32x4*)(bp + ro + bj * 128); b1 = *(const f32x4*)(bp + ro + bj * 128 + 4); }
                    else { const u32x4 w = *(const u32x4*)(xp + ro + bj * 128);
                        b0 = (f32x4){bflo(w.x), bfhi(w.x), bflo(w.y), bfhi(w.y)}; b1 = (f32x4){bflo(w.z), bfhi(w.z), bflo(w.w), bfhi(w.w)}; }
                    const f32x4 y0 = b0 + acc[ai][bj][m][0] * scale, y1 = b1 + acc[ai][bj][m][1] * scale;
                    if (MODE == 2) { *(f32x4*)(op + ro + bj * 128) = y0; *(f32x4*)(op + ro + bj * 128 + 4) = y1; }
                    else {
                        u32x4 w; w.x = cvt_pk_bf16(y0[0], y0[1]); w.y = cvt_pk_bf16(y0[2], y0[3]); w.z = cvt_pk_bf16(y1[0], y1[1]); w.w = cvt_pk_bf16(y1[2], y1[3]);
                        *(u32x4*)(xp + ro + bj * 128) = w;
                        sq += (y0[0] * y0[0] + y0[1] * y0[1]) + (y0[2] * y0[2] + y0[3] * y0[3]) + (y1[0] * y1[0] + y1[1] * y1[1]) + (y1[2] * y1[2] + y1[3] * y1[3]);
                    }
                }
                if (MODE != 2) { sq += __shfl_xor(sq, 16); sq += __shfl_xor(sq, 32); if (fq == 0) atomicAdd(ss + row0 + ai * 128 + m * 16, (unsigned long long)(sq * 1048576.f + 0.5f)); }
                asm volatile("" ::: "memory");
            }
    }
};
template <int KIND> struct EpiAB {
    static constexpr bool PERM = true, AFTER_DRAIN = false;
    bf16_t *QU, *K0, *V0, *SG, *U; const float* tab0; const unsigned long long* ss;
    __device__ __forceinline__ void operator()(const f32x4 (&acc)[2][2][4][2], const Unit& u, int wr, int wc, int fr, int fq) const {
        const int pn = u.pn + 4 * KIND, rowb = u.pm * 256 + wr * 64 + fr;
        if constexpr (KIND == 0) {
            const int head = 2 * (pn & 1) + (wc >> 1), i0 = 32 * (wc & 1) + 8 * fq;
            bf16_t* dst = pn < 2 ? QU : K0; const int ld = pn < 2 ? 1024 : 512; const float sc = pn < 2 ? 1.f : 0.08838834764831845f;
#pragma unroll
            for (int ai = 0; ai < 2; ++ai)
#pragma unroll
                for (int m = 0; m < 4; ++m) {
                    const int row = rowb + ai * 128 + m * 16, s = pos_of_row(row);
                    const float rs = __builtin_amdgcn_rsqf(ssf(ss[row]) * (1.f / D) + EPS) * sc;
                    const f32x4* tp = (const f32x4*)(tab0 + ((size_t)s * 64 + i0) * 2);
                    float o1[8], o2[8];
#pragma unroll
                    for (int n = 0; n < 2; ++n) {
                        const f32x4 ta = tp[2 * n], tb = tp[2 * n + 1]; const f32x4 x1 = acc[ai][0][m][n] * rs, x2 = acc[ai][1][m][n] * rs;
                        o1[4 * n + 0] = x1[0] * ta[0] - x2[0] * ta[1]; o2[4 * n + 0] = x2[0] * ta[0] + x1[0] * ta[1];
                        o1[4 * n + 1] = x1[1] * ta[2] - x2[1] * ta[3]; o2[4 * n + 1] = x2[1] * ta[2] + x1[1] * ta[3];
                        o1[4 * n + 2] = x1[2] * tb[0] - x2[2] * tb[1]; o2[4 * n + 2] = x2[2] * tb[0] + x1[2] * tb[1];
                        o1[4 * n + 3] = x1[3] * tb[2] - x2[3] * tb[3]; o2[4 * n + 3] = x2[3] * tb[2] + x1[3] * tb[3];
                    }
                    bf16_t* rp = dst + (size_t)row * ld + 128 * head + i0;
                    store8(rp, o1); store8(rp + 64, o2); asm volatile("" ::: "memory");
                }
        } else if constexpr (KIND == 1) {
            bf16_t* dst = pn < 6 ? V0 : SG; const bool act = pn >= 6; const int col0 = 256 * (pn & 1) + wc * 32 + 8 * fq;
#pragma unroll
            for (int ai = 0; ai < 2; ++ai)
#pragma unroll
                for (int m = 0; m < 4; ++m) {
                    const int row = rowb + ai * 128 + m * 16;
                    const float rs = __builtin_amdgcn_rsqf(ssf(ss[row]) * (1.f / D) + EPS);
#pragma unroll
                    for (int bj = 0; bj < 2; ++bj) {
                        float v[8];
#pragma unroll
                        for (int n = 0; n < 2; ++n)
#pragma unroll
                            for (int j = 0; j < 4; ++j) { const float x = acc[ai][bj][m][n][j] * rs; v[4 * n + j] = act ? siluf_(x) : x; }
                        store8(dst + (size_t)row * 512 + col0 + 128 * bj, v);
                    }
                    asm volatile("" ::: "memory");
                }
        } else {
            const int col0 = 128 * (pn - 8) + wc * 32 + 8 * fq;
#pragma unroll
            for (int ai = 0; ai < 2; ++ai)
#pragma unroll
                for (int m = 0; m < 4; ++m) {
                    const int row = rowb + ai * 128 + m * 16;
                    const float rs = __builtin_amdgcn_rsqf(ssf(ss[row]) * (1.f / D) + EPS);
                    float v[8];
#pragma unroll
                    for (int n = 0; n < 2; ++n)
#pragma unroll
                        for (int j = 0; j < 4; ++j) v[4 * n + j] = acc[ai][0][m][n][j] * rs * sigmoidf_(acc[ai][1][m][n][j] * rs);
                    store8(U + (size_t)row * 512 + col0, v); asm volatile("" ::: "memory");
                }
        }
    }
};
struct EpiABAll {
    static constexpr bool PERM = true, AFTER_DRAIN = false;
    bf16_t *QU, *K0, *V0, *SG, *U; const float* tab0; const unsigned long long* ss;
    __device__ __forceinline__ void operator()(const f32x4 (&acc)[2][2][4][2], const Unit& u, int wr, int wc, int fr, int fq) const {
        Unit v = u;
        if (u.pn < 4) { EpiAB<0>{QU, K0, V0, SG, U, tab0, ss}(acc, v, wr, wc, fr, fq); }
        else if (u.pn < 8) { v.pn = u.pn - 4; EpiAB<1>{QU, K0, V0, SG, U, tab0, ss}(acc, v, wr, wc, fr, fq); }
        else { v.pn = u.pn - 8; EpiAB<2>{QU, K0, V0, SG, U, tab0, ss}(acc, v, wr, wc, fr, fq); }
    }
};
struct EpiC {
    static constexpr bool PERM = true, AFTER_DRAIN = false;
    bf16_t *Q1, *K1, *V1; const float* tab1; const float* qg; const float* kg; const unsigned long long* ss;
    __device__ __forceinline__ void operator()(const f32x4 (&acc)[2][2][4][2], const Unit& u, int wr, int wc, int fr, int fq) const {
        const int pn = u.pn, rowb = u.pm * 256 + wr * 64 + fr;
        if (pn < 8) {
            const int group = 4 * (pn & 3) + wc, i0 = 8 * fq;
            bf16_t* dst = pn < 4 ? Q1 : K1; const float* gp = pn < 4 ? qg : kg; const float sc = pn < 4 ? 0.125f * LOG2E : 1.f;
            float g1[8], g2[8];
#pragma unroll
            for (int j = 0; j < 8; ++j) { g1[j] = gp[i0 + j] * sc; g2[j] = gp[32 + i0 + j] * sc; }
#pragma unroll
            for (int ai = 0; ai < 2; ++ai)
#pragma unroll
                for (int m = 0; m < 4; ++m) {
                    const int row = rowb + ai * 128 + m * 16, s = pos_of_row(row);
                    const float rs0 = __builtin_amdgcn_rsqf(ssf(ss[row]) * (1.f / D) + EPS);
                    float sq = 0.f;
#pragma unroll
                    for (int bj = 0; bj < 2; ++bj)
#pragma unroll
                        for (int n = 0; n < 2; ++n) { const f32x4 x = acc[ai][bj][m][n] * rs0; sq += (x[0] * x[0] + x[1] * x[1]) + (x[2] * x[2] + x[3] * x[3]); }
                    sq += __shfl_xor(sq, 16); sq += __shfl_xor(sq, 32);
                    const float rstd = __builtin_amdgcn_rsqf(sq * (1.f / 64.f) + EPS) * rs0;
                    const f32x4* tp = (const f32x4*)(tab1 + ((size_t)s * 32 + i0) * 2);
                    float o1[8], o2[8];
#pragma unroll
                    for (int n = 0; n < 2; ++n) {
                        const f32x4 ta = tp[2 * n], tb = tp[2 * n + 1]; f32x4 x1 = acc[ai][0][m][n] * rstd, x2 = acc[ai][1][m][n] * rstd;
#pragma unroll
                        for (int j = 0; j < 4; ++j) { x1[j] *= g1[4 * n + j]; x2[j] *= g2[4 * n + j]; }
                        o1[4 * n + 0] = x1[0] * ta[0] - x2[0] * ta[1]; o2[4 * n + 0] = x2[0] * ta[0] + x1[0] * ta[1];
                        o1[4 * n + 1] = x1[1] * ta[2] - x2[1] * ta[3]; o2[4 * n + 1] = x2[1] * ta[2] + x1[1] * ta[3];
                        o1[4 * n + 2] = x1[2] * tb[0] - x2[2] * tb[1]; o2[4 * n + 2] = x2[2] * tb[0] + x1[2] * tb[1];
                        o1[4 * n + 3] = x1[3] * tb[2] - x2[3] * tb[3]; o2[4 * n + 3] = x2[3] * tb[2] + x1[3] * tb[3];
                    }
                    bf16_t* rp = dst + (size_t)row * 1024 + 64 * group + i0;
                    store8(rp, o1); store8(rp + 32, o2); asm volatile("" ::: "memory");
                }
        } else {
            const int col0 = 256 * (pn - 8) + wc * 32 + 8 * fq;
#pragma unroll
            for (int ai = 0; ai < 2; ++ai)
#pragma unroll
                for (int m = 0; m < 4; ++m) {
                    const int row = rowb + ai * 128 + m * 16;
                    const float rs = __builtin_amdgcn_rsqf(ssf(ss[row]) * (1.f / D) + EPS);
#pragma unroll
                    for (int bj = 0; bj < 2; ++bj) {
                        float v[8];
#pragma unroll
                        for (int n = 0; n < 2; ++n)
#pragma unroll
                            for (int j = 0; j < 4; ++j) v[4 * n + j] = acc[ai][bj][m][n][j] * rs;
                        store8(V1 + (size_t)row * 1024 + col0 + 128 * bj, v);
                    }
                    asm volatile("" ::: "memory");
                }
        }
    }
};

__device__ __forceinline__ int perm_col(int ptype, int np) {
    const int pn = np >> 8, bj = (np >> 7) & 1, t = np & 127;
    if (ptype == 1) return bj * DFF + 128 * pn + t;
    if (ptype == 2) {
        if (pn < 4) { const int base = (pn < 2) ? 0 : 512, pl = pn & 1; return base + 256 * pl + 128 * (t >> 6) + 64 * bj + (t & 63); }
        if (pn < 8) return np;
        return 2048 + 512 * bj + 128 * (pn - 8) + t;
    }
    if (ptype == 3) {
        if (pn < 8) { const int base = (pn < 4) ? 0 : 1024, pl = pn & 3; return base + 64 * (4 * pl + (t >> 5)) + 32 * bj + (t & 31); }
        return np;
    }
    return np;
}
__device__ __forceinline__ void transpose_item(const float* W, int K, int N, int ptype, bf16_t* WT, LAS float* scr, int item, int lane, const float* gain) {
    const int nblk = N / 32, kb = item / nblk, nb = item % nblk, k0 = 64 * kb, n0 = perm_col(ptype, 32 * nb);
    float wv[32];
#pragma unroll
    for (int i = 0; i < 32; ++i) { const int kk = 2 * i + (lane >> 5); wv[i] = W[(size_t)(k0 + kk) * N + n0 + (lane & 31)]; }
    const float g0 = gain ? gain[k0 + (lane >> 5) + 2 * (lane & 31)] : 1.f;
#pragma unroll
    for (int i = 0; i < 32; ++i) { const int kk = 2 * i + (lane >> 5); scr[kk * 33 + (lane & 31)] = wv[i] * __shfl(g0, i + (lane & 32)); }
    asm volatile("s_waitcnt lgkmcnt(0)" ::: "memory");
    const int c = lane & 7;
#pragma unroll
    for (int j = 0; j < 4; ++j) { const int n = (lane >> 3) + 8 * j; const LAS float* s = scr + (8 * c) * 33 + n;
        u32x4 o; o.x = cvt_pk_bf16(s[0 * 33], s[1 * 33]); o.y = cvt_pk_bf16(s[2 * 33], s[3 * 33]); o.z = cvt_pk_bf16(s[4 * 33], s[5 * 33]); o.w = cvt_pk_bf16(s[6 * 33], s[7 * 33]);
        *(u32x4*)(WT + (size_t)(32 * nb + n) * K + k0 + 8 * c) = o; }
    asm volatile("s_waitcnt lgkmcnt(0)" ::: "memory");
}
__device__ __forceinline__ void rms_row_to_bf16(const float* xrow, float* ssrow, bf16_t* orow, int lane) {
    const f32x4* xr = (const f32x4*)xrow + lane;
    f32x4 v[4]; float s = 0.f;
#pragma unroll
    for (int j = 0; j < 4; ++j) { v[j] = xr[64 * j]; s += (v[j][0] * v[j][0] + v[j][1] * v[j][1]) + (v[j][2] * v[j][2] + v[j][3] * v[j][3]); }
    const float tot = wave_sum(s);
    if (lane == 0) *ssrow = tot;
    unsigned long long* o8 = (unsigned long long*)orow + lane;
#pragma unroll
    for (int j = 0; j < 4; ++j) { const f32x4 y = v[j];
        o8[64 * j] = (unsigned long long)cvt_pk_bf16(y[0], y[1]) | ((unsigned long long)cvt_pk_bf16(y[2], y[3]) << 32); }
}
__device__ __forceinline__ void norm_phase(const float* xA, const float* xB, unsigned long long* ss, bf16_t* XN, int gw, int lane) {
    for (int m0 = gw; m0 < M; m0 += 4 * 2048) {
        f32x4 v[4][4];
#pragma unroll
        for (int q = 0; q < 4; ++q) { const int m = m0 + 2048 * q; const float* xr = m < NPROMPT ? xA + (size_t)m * D : xB + (size_t)(m - NPROMPT) * D;
#pragma unroll
            for (int j = 0; j < 4; ++j) v[q][j] = ((const f32x4*)xr + lane)[64 * j]; }
#pragma unroll
        for (int q = 0; q < 4; ++q) { const int m = m0 + 2048 * q; float s = 0.f;
#pragma unroll
            for (int j = 0; j < 4; ++j) s += (v[q][j][0] * v[q][j][0] + v[q][j][1] * v[q][j][1]) + (v[q][j][2] * v[q][j][2] + v[q][j][3] * v[q][j][3]);
            const float tot = wave_sum(s);
            if (lane == 0) ss[m] = (unsigned long long)(tot * 1048576.f + 0.5f);
            unsigned long long* o8 = (unsigned long long*)(XN + (size_t)m * D) + lane;
#pragma unroll
            for (int j = 0; j < 4; ++j) o8[64 * j] = (unsigned long long)cvt_pk_bf16(v[q][j][0], v[q][j][1]) | ((unsigned long long)cvt_pk_bf16(v[q][j][2], v[q][j][3]) << 32); }
    }
}
__device__ __forceinline__ void rope_entry(float* tab, int half, int idx) {
    const int s = idx / half, i = idx % half;
    const float inv = exp2f(-(float)i / (float)half * 13.287712379549449f);
    const float ang = (float)s * inv;
    const double a = (double)ang;
    const double k = rint(a * 0.15915494309189535);
    double r = fma(-k, 6.283185307179586, a); r = fma(-k, 2.4492935982947064e-16, r);
    const float rf = (float)r;
    tab[2 * (size_t)idx] = cosf(rf); tab[2 * (size_t)idx + 1] = sinf(rf);
}

__device__ __forceinline__ void r1_unit(ldsp lds, int uidx, const bf16_t* K0, const bf16_t* V0, bf16_t* KV, float lgf2, float lgb2) {
    const int tid = otid(), lane = tid & 63, wid = __builtin_amdgcn_readfirstlane(tid >> 6), r32 = lane & 31, hi = lane >> 5;
    const int gc = uidx >> 2, h = uidx & 3, r0 = gc * 128;
    ldsp Kimg = lds, Vf = lds + 40960, Vb = lds + 81920;
#pragma unroll
    for (int i = 0; i < 4; ++i) {
        const int cidx = tid + 512 * i, key = cidx >> 4, ch = cidx & 15;
        const u32x4 kv = *(const u32x4*)(K0 + (size_t)(r0 + key) * 512 + 128 * h + 8 * ch);
        const u32x4 vv = *(const u32x4*)(V0 + (size_t)(r0 + key) * 512 + 128 * h + 8 * ch);
        *(LAS u32x4*)(Kimg + key * 320 + ch * 16) = kv;
        const float df = ex2(lgf2 * (float)(127 - key)), db = ex2(lgb2 * (float)key);
        u32x4 wf, wb;
        wf.x = cvt_pk_bf16(bflo(vv.x) * df, bfhi(vv.x) * df); wf.y = cvt_pk_bf16(bflo(vv.y) * df, bfhi(vv.y) * df);
        wf.z = cvt_pk_bf16(bflo(vv.z) * df, bfhi(vv.z) * df); wf.w = cvt_pk_bf16(bflo(vv.w) * df, bfhi(vv.w) * df);
        wb.x = cvt_pk_bf16(bflo(vv.x) * db, bfhi(vv.x) * db); wb.y = cvt_pk_bf16(bflo(vv.y) * db, bfhi(vv.y) * db);
        wb.z = cvt_pk_bf16(bflo(vv.z) * db, bfhi(vv.z) * db); wb.w = cvt_pk_bf16(bflo(vv.w) * db, bfhi(vv.w) * db);
        *(LAS u32x4*)(Vf + key * 320 + ch * 16) = wf;
        *(LAS u32x4*)(Vb + key * 320 + ch * 16) = wb;
    }
    __syncthreads();
    const int dir = wid >> 2, dblk = wid & 3;
    ldsp Vimg = dir ? Vb : Vf;
    const int trow = (lane & 15) >> 2, tcol = 16 * ((lane >> 4) & 1) + 4 * (lane & 3);
    f32x16 acc[4];
#pragma unroll
    for (int eb = 0; eb < 4; ++eb)
#pragma unroll
        for (int r = 0; r < 16; ++r) acc[eb][r] = 0.f;
#pragma unroll
    for (int s = 0; s < 8; ++s) {
        const int krow = 16 * s + 8 * hi + trow;
        const bf16x8 af = tr_frag(Kimg + krow * 320 + (32 * dblk + tcol) * 2, 4 * 320);
#pragma unroll
        for (int eb = 0; eb < 4; ++eb) {
            const bf16x8 bfr = tr_frag(Vimg + krow * 320 + (32 * eb + tcol) * 2, 4 * 320);
            acc[eb] = mfma32(af, bfr, acc[eb]);
        }
    }
    bf16_t* op = KV + (size_t)(uidx * 2 + dir) * 16384;
#pragma unroll
    for (int eb = 0; eb < 4; ++eb)
#pragma unroll
        for (int r = 0; r < 16; ++r) op[(32 * dblk + crow(r, hi)) * 128 + 32 * eb + r32] = f2bf(acc[eb][r]);
    __syncthreads();
}
__device__ __forceinline__ void conv_tile(ldsp lds, int tile, const bf16_t* U, const float* cw, const float* cb, const float* cg, bf16_t* QU) {
    const int tid = otid(), lane = tid & 63, wid = __builtin_amdgcn_readfirstlane(tid >> 6);
    const int t0 = tile * 32;
    const int seq_lo = t0 < NPROMPT ? (t0 & ~4095) : (t0 & ~8191), seq_hi = seq_lo + (t0 < NPROMPT ? 4096 : 8192);
    LAS unsigned short* Ut = (LAS unsigned short*)lds;
    LAS float* Y = (LAS float*)(lds + 65536);
    LAS float* part = (LAS float*)(lds + 65536 + 65536);
    for (int cidx = tid; cidx < 62 * 64; cidx += 512) {
        const int rr = cidx >> 6, ch = cidx & 63, grow = t0 - 15 + rr;
        u32x4 v = (u32x4){0u, 0u, 0u, 0u};
        if (grow >= seq_lo && grow < seq_hi) v = *(const u32x4*)(U + (size_t)grow * 512 + 8 * ch);
        *(LAS u32x4*)(lds + rr * 1024 + ch * 16) = v;
    }
    float w[31];
#pragma unroll
    for (int k = 0; k < 31; ++k) w[k] = cw[k * 512 + tid];
    const float bias = cb[tid], gain = cg[tid];
    __syncthreads();
    float xin[62];
#pragma unroll
    for (int k = 0; k < 62; ++k) xin[k] = bf2f(Ut[k * 512 + tid]);
#pragma unroll
    for (int tt = 0; tt < 32; ++tt) {
        float y = bias;
#pragma unroll
        for (int k = 0; k < 31; ++k) y += xin[tt + k] * w[k];
        Y[tt * 512 + tid] = y;
        const float s = wave_sum(y * y);
        if (lane == 0) part[wid * 32 + tt] = s;
    }
    __syncthreads();
    for (int tt = 0; tt < 32; ++tt) {
        float ss = 0.f;
#pragma unroll
        for (int k = 0; k < 8; ++k) ss += part[k * 32 + tt];
        const float rstd = __builtin_amdgcn_rsqf(ss * (1.f / 512.f) + EPS);
        const float v = Y[tt * 512 + tid] * rstd * gain;
        QU[(size_t)(t0 + tt) * 1024 + 512 + tid] = f2bf(siluf_(v));
    }
    __syncthreads();
}
__device__ __forceinline__ void scan_phase(bf16_t* KV, const float* decay, int gtid) {
    if (gtid >= 98304) return;
    const int v = gtid & 2047, rest = gtid >> 11, dir = rest & 1, h = (rest >> 1) & 3, seq = rest >> 3;
    const int nc = seq < 4 ? 32 : 64, gc0 = seq < 4 ? seq * 32 : 128 + (seq - 4) * 64;
    const float lg = -expf(decay[dir * 4 + h]);
    const float cd = expf(lg * 128.f);
    float st[8];
#pragma unroll
    for (int j = 0; j < 8; ++j) st[j] = 0.f;
    for (int b = 0; b < nc; b += 8) {
        u32x4 buf[8];
#pragma unroll
        for (int i = 0; i < 8; ++i) { const int lc = dir ? (nc - 1 - (b + i)) : (b + i);
            buf[i] = *(const u32x4*)(KV + ((size_t)((gc0 + lc) * 4 + h) * 2 + dir) * 16384 + v * 8); }
#pragma unroll
        for (int i = 0; i < 8; ++i) { const int lc = dir ? (nc - 1 - (b + i)) : (b + i);
            u32x4 o; o.x = cvt_pk_bf16(st[0], st[1]); o.y = cvt_pk_bf16(st[2], st[3]); o.z = cvt_pk_bf16(st[4], st[5]); o.w = cvt_pk_bf16(st[6], st[7]);
            *(u32x4*)(KV + ((size_t)((gc0 + lc) * 4 + h) * 2 + dir) * 16384 + v * 8) = o;
            st[0] = st[0] * cd + bflo(buf[i].x); st[1] = st[1] * cd + bfhi(buf[i].x); st[2] = st[2] * cd + bflo(buf[i].y); st[3] = st[3] * cd + bfhi(buf[i].y);
            st[4] = st[4] * cd + bflo(buf[i].z); st[5] = st[5] * cd + bfhi(buf[i].z); st[6] = st[6] * cd + bflo(buf[i].w); st[7] = st[7] * cd + bfhi(buf[i].w); }
    }
}
__device__ __forceinline__ void r3_unit(ldsp lds, int uidx, bf16_t* QU, const bf16_t* K0, const bf16_t* V0, const bf16_t* SG, const bf16_t* KV, const float* retg, float lgf2, float lgb2) {
    const int tid = otid(), lane = tid & 63, wid = __builtin_amdgcn_readfirstlane(tid >> 6), r32 = lane & 31, hi = lane >> 5;
    const int gc = uidx >> 2, h = uidx & 3, r0 = gc * 128;
    const int qb = wid & 3, eh = wid >> 2;
    ldsp bufA = lds, bufB = lds + 34816, bufC = lds + 75776; LAS float* ssx = (LAS float*)(lds + 116736);
    bf16x8 qf[8];
    { const bf16_t* qp = QU + (size_t)(r0 + 32 * qb + r32) * 1024 + 128 * h + 8 * hi;
#pragma unroll
      for (int s = 0; s < 8; ++s) qf[s] = *(const bf16x8*)(qp + 16 * s); }
#pragma unroll
    for (int i = 0; i < 4; ++i) {
        const int cidx = tid + 512 * i, key = cidx >> 4, ch = cidx & 15;
        *(LAS u32x4*)(bufA + key * 272 + ch * 16) = *(const u32x4*)(K0 + (size_t)(r0 + key) * 512 + 128 * h + 8 * ch);
        *(LAS u32x4*)(bufB + key * 320 + ch * 16) = *(const u32x4*)(KV + (size_t)(uidx * 2 + 0) * 16384 + key * 128 + 8 * ch);
        *(LAS u32x4*)(bufC + key * 320 + ch * 16) = *(const u32x4*)(KV + (size_t)(uidx * 2 + 1) * 16384 + key * 128 + 8 * ch);
    }
    __syncthreads();
    const int trow = (lane & 15) >> 2, tcol = 16 * ((lane >> 4) & 1) + 4 * (lane & 3);
    f32x16 ot[2];
    {
        f32x16 af[2], ab[2];
#pragma unroll
        for (int e2 = 0; e2 < 2; ++e2)
#pragma unroll
            for (int r = 0; r < 16; ++r) { af[e2][r] = 0.f; ab[e2][r] = 0.f; }
#pragma unroll
        for (int s = 0; s < 8; ++s) {
            const int drow = 16 * s + 8 * hi + trow;
#pragma unroll
            for (int e2 = 0; e2 < 2; ++e2) {
                const int eb = 2 * eh + e2;
                const bf16x8 f1 = tr_frag(bufB + drow * 320 + (32 * eb + tcol) * 2, 4 * 320);
                af[e2] = mfma32(qf[s], f1, af[e2]);
                const bf16x8 f2 = tr_frag(bufC + drow * 320 + (32 * eb + tcol) * 2, 4 * 320);
                ab[e2] = mfma32(qf[s], f2, ab[e2]);
            }
        }
#pragma unroll
        for (int r = 0; r < 16; ++r) {
            const int irow = 32 * qb + crow(r, hi);
            const float sf = ex2(lgf2 * (float)(irow + 1)), sb = ex2(lgb2 * (float)(128 - irow));
#pragma unroll
            for (int e2 = 0; e2 < 2; ++e2) ot[e2][r] = af[e2][r] * sf + ab[e2][r] * sb;
        }
    }
    __syncthreads();
#pragma unroll
    for (int i = 0; i < 4; ++i) {
        const int cidx = tid + 512 * i, key = cidx >> 4, ch = cidx & 15;
        *(LAS u32x4*)(bufB + key * 320 + ch * 16) = *(const u32x4*)(V0 + (size_t)(r0 + key) * 512 + 128 * h + 8 * ch);
    }
    __syncthreads();
    {
        f32x16 p[4];
#pragma unroll
        for (int kb = 0; kb < 4; ++kb)
#pragma unroll
            for (int r = 0; r < 16; ++r) p[kb][r] = 0.f;
#pragma unroll
        for (int s = 0; s < 8; ++s)
#pragma unroll
            for (int kb = 0; kb < 4; ++kb) {
                const bf16x8 a = *(const LAS bf16x8*)(bufA + (32 * kb + r32) * 272 + (16 * s + 8 * hi) * 2);
                p[kb] = mfma32(a, qf[s], p[kb]);
            }
        const int iq = 32 * qb + r32;
        bf16x8 pa[8];
#pragma unroll
        for (int kb = 0; kb < 4; ++kb) {
#pragma unroll
            for (int r = 0; r < 16; ++r) {
                const int j = 32 * kb + crow(r, hi), dl = iq - j;
                const float wgt = dl >= 0 ? ex2(lgf2 * (float)dl) : ex2(lgb2 * (float)(-dl));
                p[kb][r] *= wgt;
            }
            pa[2 * kb] = pack8(p[kb][0], p[kb][1], p[kb][2], p[kb][3], p[kb][4], p[kb][5], p[kb][6], p[kb][7]);
            pa[2 * kb + 1] = pack8(p[kb][8], p[kb][9], p[kb][10], p[kb][11], p[kb][12], p[kb][13], p[kb][14], p[kb][15]);
        }
#pragma unroll
        for (int ks = 0; ks < 8; ++ks) {
            const int vrow = 16 * ks + 4 * hi + trow;
#pragma unroll
            for (int e2 = 0; e2 < 2; ++e2) {
                const int eb = 2 * eh + e2;
                const bf16x8 vf = tr_frag(bufB + vrow * 320 + (32 * eb + tcol) * 2, 8 * 320);
                ot[e2] = mfma32(pa[ks], vf, ot[e2]);
            }
        }
    }
#pragma unroll
    for (int r = 0; r < 16; ++r) {
        float ss = ot[0][r] * ot[0][r] + ot[1][r] * ot[1][r];
        ss = sum32(ss);
        if (r32 == 0) ssx[(qb * 32 + crow(r, hi)) * 2 + eh] = ss;
    }
    __syncthreads();
#pragma unroll
    for (int r = 0; r < 16; ++r) {
        const int lr = qb * 32 + crow(r, hi);
        const float rstd = __builtin_amdgcn_rsqf((ssx[lr * 2] + ssx[lr * 2 + 1]) * (1.f / 128.f) + EPS);
#pragma unroll
        for (int e2 = 0; e2 < 2; ++e2) {
            const int e = 128 * h + 32 * (2 * eh + e2) + r32;
            const float gate = bf2f(SG[(size_t)(r0 + lr) * 512 + e]);
            QU[(size_t)(r0 + lr) * 1024 + e] = f2bf(ot[e2][r] * rstd * retg[e] * gate);
        }
    }
    __syncthreads();
}

__device__ __forceinline__ float shx(float v, int lane, int o) { return __builtin_bit_cast(float, __builtin_amdgcn_ds_bpermute((lane ^ o) << 2, __builtin_bit_cast(int, v))); }
__device__ __forceinline__ void glds16(const void* gsrc, unsigned lds_dst) { unsigned keep;
    asm volatile("s_mov_b32 %0, m0\n\ts_mov_b32 m0, %2\n\ts_nop 0\n\tglobal_load_lds_dwordx4 %1, off\n\ts_mov_b32 m0, %0" : "=&s"(keep) : "v"(gsrc), "s"(lds_dst) : "memory"); }
__device__ __forceinline__ unsigned dma_off(int y, int P) { const int row = y / P, cw = y - P * row; return (unsigned)(row * 1024 + (cw < 16 ? cw : 15) * 8) * 2u; }
__device__ __forceinline__ void glds16s(const void* gbase, unsigned voff, unsigned lds_dst) { unsigned keep;
    asm volatile("s_mov_b32 %0, m0\n\ts_mov_b32 m0, %3\n\ts_nop 0\n\tglobal_load_lds_dwordx4 %1, %2\n\ts_mov_b32 m0, %0" : "=&s"(keep) : "v"(voff), "s"(gbase), "s"(lds_dst) : "memory"); }
#define ATTN_DMA(KOFS, VOFS, KT_BASE, VT_BASE) do { \
        const unsigned l0_ = (unsigned)(uintptr_t)lds + 1024u * (unsigned)wid; \
        glds16s(KT_BASE, dk0, l0_ + (KOFS)); glds16s(KT_BASE, dk1, l0_ + (KOFS) + 8192u); if (wid == 0) glds16s(KT_BASE, dk2, l0_ + (KOFS) + 16384u); \
        glds16s(VT_BASE, dv0, l0_ + (VOFS)); glds16s(VT_BASE, dv1, l0_ + (VOFS) + 8192u); if (wid < 4) glds16s(VT_BASE, dv2, l0_ + (VOFS) + 16384u); } while (0)
__device__ __forceinline__ void attn_phase(ldsp lds, const bf16_t* Q1, const bf16_t* K1, const bf16_t* V1, bf16_t* O,
                                           const float* lamp, const float* subg, int vcu) {
    const int wid = __builtin_amdgcn_readfirstlane(otid() >> 6);
    float lam_full;
    { const int lane = otid() & 63; const float la = wave_sum(lamp[lane] * lamp[64 + lane]), lb = wave_sum(lamp[128 + lane] * lamp[192 + lane]);
      lam_full = __builtin_bit_cast(float, __builtin_amdgcn_readfirstlane(__builtin_bit_cast(int, expf(la) - expf(lb) + LINIT1))); }
    for (int ui = 0; ui < 4; ++ui) {
        const int u = vcu + 256 * (ui & 1);
        int S, row0, head, qb;
        if (ui < 2) { S = 4096; row0 = (u >> 7) * 4096; head = (u >> 4) & 7; qb = u & 15; }
        else { S = 8192; row0 = NPROMPT + (u >> 8) * 8192; head = (u >> 5) & 7; qb = u & 31; }
        const int NT = S / 64;
        const int qrow0 = row0 + qb * 256 + wid * 32;
        ldsp Qw = lds + 77824 + wid * 8704;
        { const int lane = otid() & 63;
#pragma unroll
          for (int i = 0; i < 8; ++i) { const int idx = lane + 64 * i, row = idx >> 4, ch = idx & 15;
              *(LAS u32x4*)(Qw + row * 272 + ch * 16) = *(const u32x4*)(Q1 + (size_t)(qrow0 + row) * 1024 + 128 * head + 8 * ch); } }
        const bf16_t* kbase = K1 + (size_t)row0 * 1024 + 128 * head; const bf16_t* vbase = V1 + (size_t)row0 * 1024 + 128 * head;
        f32x16 o[2][4];
#pragma unroll
        for (int c = 0; c < 2; ++c)
#pragma unroll
            for (int eb = 0; eb < 4; ++eb)
#pragma unroll
                for (int r = 0; r < 16; ++r) o[c][eb][r] = 0.f;
        float l0 = 0.f, l1 = 0.f;
        unsigned dk0, dk1, dk2, dv0, dv1, dv2;
        { const int lane = otid() & 63; dk0 = dma_off(64 * wid + lane, 17); dk1 = dma_off(64 * (wid + 8) + lane, 17); dk2 = dma_off(64 * 16 + lane, 17);
          dv0 = dma_off(64 * wid + lane, 20); dv1 = dma_off(64 * (wid + 8) + lane, 20); dv2 = dma_off(64 * (wid + 16) + lane, 20); }
        ATTN_DMA(0u, 34816u, kbase, vbase);
        asm volatile("s_waitcnt vmcnt(0)" ::: "memory");
        __syncthreads();
        for (int kt = 0; kt < NT; ++kt) {
            const int cur = kt & 1;
            const bool more = (kt + 1 < NT);
            const int tid = otid(), lane = tid & 63, r32 = lane & 31, hi = lane >> 5;
            const int trow = (lane & 15) >> 2, tcol = 16 * ((lane >> 4) & 1) + 4 * (lane & 3);
            ldsp Kb = lds + cur * 17408 + r32 * 272 + 16 * hi, Vb = lds + 34816 + cur * 20480 + (4 * hi + trow) * 320 + tcol * 2;
            ldsp qrd = Qw + r32 * 272 + 16 * hi;
            if (more) ATTN_DMA((unsigned)(cur ^ 1) * 17408u, 34816u + (unsigned)(cur ^ 1) * 20480u, kbase + (size_t)(kt + 1) * 64 * 1024, vbase + (size_t)(kt + 1) * 64 * 1024);
#define SBAR_ __builtin_amdgcn_sched_barrier(0)
#define SQL(C, S) do { kf0[S] = *(const LAS bf16x8*)(Kb + (64 * (C) + 16 * (S)) * 2); kf1[S] = *(const LAS bf16x8*)(Kb + 32 * 272 + (64 * (C) + 16 * (S)) * 2); \
        qfv[S] = *(const LAS bf16x8*)(qrd + (64 * (C) + 16 * (S)) * 2); } while (0)
#define SQM(S, P0, P1) do { __builtin_amdgcn_s_setprio(1); P0 = mfma32(kf0[S], qfv[S], P0); P1 = mfma32(kf1[S], qfv[S], P1); __builtin_amdgcn_s_setprio(0); } while (0)
#define SQT(C, P0, P1, HOOK) do { _Pragma("unroll") for (int r = 0; r < 16; ++r) { P0[r] = 0.f; P1[r] = 0.f; } \
        SQL(C, 1); SBAR_; SQM(0, P0, P1); SQL(C, 2); SBAR_; SQM(1, P0, P1); SQL(C, 3); SBAR_; SQM(2, P0, P1); HOOK; SBAR_; SQM(3, P0, P1); SBAR_; } while (0)
#define VFL2(VF, KS, H) do { VF[2 * (H)] = tr_frag(Vb + 16 * (KS) * 320 + 64 * (2 * (H)), 8 * 320); VF[2 * (H) + 1] = tr_frag(Vb + 16 * (KS) * 320 + 64 * (2 * (H) + 1), 8 * 320); } while (0)
#define VFL(VF, KS) do { VFL2(VF, KS, 0); VFL2(VF, KS, 1); } while (0)
#define VWORK(P, B, G, W, RS) do { const float e0_ = ex2(P[(B) + 2 * (G)]), e1_ = ex2(P[(B) + 2 * (G) + 1]); RS += e0_ + e1_; W[G] = cvt_pk_bf16(e0_, e1_); } while (0)
#define GRP(OC, WCUR, VFCUR, VFNEXT, KSNEXT, P, B, WNEXT, RS, PRE) do { __builtin_amdgcn_s_setprio(1); \
        OC[0] = mfma32(__builtin_bit_cast(bf16x8, WCUR), VFCUR[0], OC[0]); if (PRE) VFL2(VFNEXT, KSNEXT, 0); VWORK(P, B, 0, WNEXT, RS); SBAR_; \
        OC[1] = mfma32(__builtin_bit_cast(bf16x8, WCUR), VFCUR[1], OC[1]); VWORK(P, B, 1, WNEXT, RS); SBAR_; \
        OC[2] = mfma32(__builtin_bit_cast(bf16x8, WCUR), VFCUR[2], OC[2]); if (PRE) VFL2(VFNEXT, KSNEXT, 1); VWORK(P, B, 2, WNEXT, RS); SBAR_; \
        OC[3] = mfma32(__builtin_bit_cast(bf16x8, WCUR), VFCUR[3], OC[3]); VWORK(P, B, 3, WNEXT, RS); __builtin_amdgcn_s_setprio(0); SBAR_; } while (0)
            {
                f32x16 pA0, pA1, pB0, pB1; u32x4 wA, wB; bf16x8 vfA[4], vfB[4], kf0[4], kf1[4], qfv[4];
                SQL(0, 0); SBAR_;
                SQT(0, pA0, pA1, (void)0);
                VFL(vfA, 0);
                VWORK(pA0, 0, 0, wA, l0); VWORK(pA0, 0, 1, wA, l0); VWORK(pA0, 0, 2, wA, l0); VWORK(pA0, 0, 3, wA, l0); SBAR_;
                GRP(o[0], wA, vfA, vfB, 1, pA0, 8, wB, l0, true);
                GRP(o[0], wB, vfB, vfA, 2, pA1, 0, wA, l0, true);
                GRP(o[0], wA, vfA, vfB, 3, pA1, 8, wB, l0, false);
                SQL(1, 0); SBAR_;
                SQT(1, pB0, pB1, VFL(vfB, 3));
                GRP(o[0], wB, vfB, vfA, 0, pB0, 0, wA, l1, true);
                GRP(o[1], wA, vfA, vfB, 1, pB0, 8, wB, l1, true);
                GRP(o[1], wB, vfB, vfA, 2, pB1, 0, wA, l1, true);
                GRP(o[1], wA, vfA, vfB, 3, pB1, 8, wB, l1, true);
#pragma unroll
                for (int eb = 0; eb < 4; ++eb) o[1][eb] = mfma32(__builtin_bit_cast(bf16x8, wB), vfB[eb], o[1][eb]);
                SBAR_;
            }
#undef SQT
#undef SQL
#undef SQM
#undef VFL
#undef VWORK
#undef GRP
#undef SBAR_
            asm volatile("s_waitcnt vmcnt(0)" ::: "memory");
            __syncthreads();
        }
        {
            const int lane = otid() & 63, r32 = lane & 31, hi = lane >> 5;
            LAS float* lsc = (LAS float*)(lds + 75776) + wid * 64;
            l0 += shx(l0, lane, 32); l1 += shx(l1, lane, 32);
            if (hi == 0) { lsc[r32] = l0; lsc[32 + r32] = l1; }
            asm volatile("s_waitcnt lgkmcnt(0)" ::: "memory");
            const float g0 = subg[r32], g1 = subg[32 + r32], g2 = subg[64 + r32], g3 = subg[96 + r32];
#pragma unroll
            for (int r = 0; r < 16; ++r) {
                const int lr = crow(r, hi);
                const float i0 = __builtin_amdgcn_rcpf(lsc[lr]), i1 = lam_full * __builtin_amdgcn_rcpf(lsc[32 + lr]);
                const float v0 = o[0][0][r] * i0 - o[1][0][r] * i1, v1 = o[0][1][r] * i0 - o[1][1][r] * i1;
                const float v2 = o[0][2][r] * i0 - o[1][2][r] * i1, v3 = o[0][3][r] * i0 - o[1][3][r] * i1;
                float ss = (v0 * v0 + v1 * v1) + (v2 * v2 + v3 * v3);
                ss += shx(ss, lane, 1); ss += shx(ss, lane, 2); ss += shx(ss, lane, 4); ss += shx(ss, lane, 8); ss += shx(ss, lane, 16);
                const float rstd = __builtin_amdgcn_rsqf(ss * (1.f / 128.f) + EPS) * (1.f - LINIT1);
                bf16_t* op = O + (size_t)(qrow0 + lr) * 1024 + 128 * head + r32;
                op[0] = f2bf(v0 * rstd * g0); op[32] = f2bf(v1 * rstd * g1); op[64] = f2bf(v2 * rstd * g2); op[96] = f2bf(v3 * rstd * g3);
            }
            asm volatile("s_waitcnt lgkmcnt(0)" ::: "memory");
        }
    }
}

struct Args { const float* in[18]; float* out; unsigned char* ws; int ph_lo, ph_hi; };
constexpr int N_PHASES = 17;

template <class Epi>
__device__ __forceinline__ void run_gemm(ldsp lds, const bf16_t* A, const bf16_t* Bt, int N, int K, const Epi& E) {
    pg8::Gemm g{A, Bt, M, N, K}; pg8::StaticOrder S; S.init(M, N, 256, obx());
#ifndef NO_GEMM
    pg8::gemm_phase<Epi, pg8::StaticOrder, true, true>(lds, g, S, E);
#endif
}
#define WSP(off) ((bf16_t*)(a.ws + (off)))
#define SSP(k) ((unsigned long long*)(a.ws + WS_SS) + (size_t)(k) * M)
__device__ __forceinline__ void ph_prologue(const Args& a, ldsp lds) {
    const int tid = otid(), lane = tid & 63, wid = __builtin_amdgcn_readfirstlane(tid >> 6), bx = obx(), gw = bx * 8 + wid;
    LAS float* scr = (LAS float*)(lds + wid * 16384);
    constexpr int I_FFI = 16 * 176, I_FFO = 44 * 32, I_IN = 16 * 96, I_OUT = 16 * 32;
    constexpr int NITEMS = 4 * I_FFI + 4 * I_FFO + 2 * I_IN + 2 * I_OUT;
    const float* ng = a.in[2];
    for (int it = gw; it < NITEMS; it += 2048) {
        int r = it;
        if (r < 4 * I_FFI) { const int mi = r / I_FFI; const int gi = (mi >> 1) * 3 + ((mi & 1) ? 2 : 0);
            transpose_item(a.in[3] + (size_t)mi * 1024 * 5632, 1024, 5632, 1, WSP(WS_FFI + mi * W_FFI), scr, r % I_FFI, lane, ng + gi * D); continue; } r -= 4 * I_FFI;
        if (r < 4 * I_FFO) { const int mi = r / I_FFO; transpose_item(a.in[4] + (size_t)mi * 2816 * 1024, 2816, 1024, 0, WSP(WS_FFO + mi * W_FFO), scr, r % I_FFO, lane, nullptr); continue; } r -= 4 * I_FFO;
        if (r < I_IN) { transpose_item(a.in[5], 1024, 3072, 2, WSP(WS_ABI), scr, r, lane, ng + 1 * D); continue; } r -= I_IN;
        if (r < I_IN) { transpose_item(a.in[12], 1024, 3072, 3, WSP(WS_CI), scr, r, lane, ng + 4 * D); continue; } r -= I_IN;
        if (r < I_OUT) { transpose_item(a.in[11], 1024, 1024, 0, WSP(WS_ABO), scr, r, lane, nullptr); continue; } r -= I_OUT;
        transpose_item(a.in[17], 1024, 1024, 0, WSP(WS_CO), scr, r, lane, nullptr);
    }
    float* tab0 = (float*)(a.ws + WS_TAB0); float* tab1 = (float*)(a.ws + WS_TAB1);
    for (int e = bx * 512 + tid; e < 8192 * 96; e += 256 * 512) { if (e < 8192 * 64) rope_entry(tab0, 64, e); else rope_entry(tab1, 32, e - 8192 * 64); }
    for (int e = bx * 512 + tid; e < 5 * M; e += 256 * 512) SSP(1)[e] = 0ull;
    norm_phase(a.in[0], a.in[1], SSP(0), WSP(WS_XN), gw, lane);
}
__device__ __forceinline__ void ph_ffn_in(const Args& a, ldsp lds, int wi, int k) { run_gemm(lds, WSP(WS_XN), WSP(WS_FFI + (size_t)wi * W_FFI), 5632, 1024, EpiSwiglu{WSP(WS_H), SSP(k)}); }
template <int MODE>
__device__ __forceinline__ void ph_ffn_out(const Args& a, ldsp lds, int wi, int k) {
    run_gemm(lds, WSP(WS_H), WSP(WS_FFO + (size_t)wi * W_FFO), 1024, 2816, EpiResid<MODE>{a.in[0], a.in[1], a.out, 0.5f, WSP(WS_XN), SSP(k)});
}
__device__ __forceinline__ void ph_outproj(const Args& a, ldsp lds, size_t aoff, size_t woff, int k) {
    run_gemm(lds, WSP(aoff), WSP(woff), 1024, 1024, EpiResid<1>{a.in[0], a.in[1], a.out, 1.0f, WSP(WS_XN), SSP(k)});
}

__global__ void __launch_bounds__(512, 2) fwd_kernel(Args a_in) {
    extern __shared__ __attribute__((aligned(16))) unsigned char lds_raw[];
    cg::grid_group grid = cg::this_grid();
    ldsp lds = (ldsp)lds_raw;
    const Args& a0 = a_in;
    if (threadIdx.x < 16) ((LAS unsigned*)(lds + LDS_MISC))[threadIdx.x] = 0u;
    __syncthreads();
    XcdBarrier bar = xcd_barrier_post((unsigned*)(a_in.ws + WS_CTL), (volatile LAS unsigned*)(lds + LDS_MISC));
    for (int ph = a0.ph_lo; ph < a0.ph_hi; ++ph) {
        Args a = a0; asm volatile("" : "+s"(a.ws), "+s"(a.out));
        switch (ph) {
        case 0: ph_prologue(a, lds); break;
        case 1: ph_ffn_in(a, lds, 0, 0); break;
        case 2: ph_ffn_out<0>(a, lds, 0, 1); break;
        case 3:
            run_gemm(lds, WSP(WS_XN), WSP(WS_ABI), 3072, 1024, EpiABAll{WSP(WS_QU), WSP(WS_K0), WSP(WS_V0), WSP(WS_SG), WSP(WS_U), (const float*)(a.ws + WS_TAB0), SSP(1)});
            break;
        case 4: {
            const int bx = obx(); const float lgf2 = -expf(a.in[6][(bx & 3)]) * LOG2E, lgb2 = -expf(a.in[6][4 + (bx & 3)]) * LOG2E;
            for (int i = 0; i < 4; ++i) r1_unit(lds, bx + 256 * i, WSP(WS_K0), WSP(WS_V0), (bf16_t*)a.out, lgf2, lgb2);
            for (int i = 0; i < 4; ++i) conv_tile(lds, bx + 256 * i, WSP(WS_U), a.in[8], a.in[9], a.in[10], WSP(WS_QU));
        } break;
        case 5: scan_phase((bf16_t*)a.out, a.in[6], obx() * 512 + otid()); break;
        case 6: {
            const int bx = obx(); const float lgf2 = -expf(a.in[6][(bx & 3)]) * LOG2E, lgb2 = -expf(a.in[6][4 + (bx & 3)]) * LOG2E;
            for (int i = 0; i < 4; ++i) r3_unit(lds, bx + 256 * i, WSP(WS_QU), WSP(WS_K0), WSP(WS_V0), WSP(WS_SG), (bf16_t*)a.out, a.in[7], lgf2, lgb2);
        } break;
        case 7: ph_outproj(a, lds, WS_QU, WS_ABO, 2); break;
        case 8: ph_ffn_in(a, lds, 1, 2); break;
        case 9: ph_ffn_out<1>(a, lds, 1, 3); break;
        case 10: ph_ffn_in(a, lds, 2, 3); break;
        case 11: ph_ffn_out<1>(a, lds, 2, 4); break;
        case 12: run_gemm(lds, WSP(WS_XN), WSP(WS_CI), 3072, 1024, EpiC{WSP(WS_Q1), WSP(WS_K1), WSP(WS_V1), (const float*)(a.ws + WS_TAB1), a.in[13], a.in[14], SSP(4)}); break;
        case 13: {
            const int bx = obx(); const int vcu = (bx % 8) * 32 + bx / 8;
            attn_phase(lds, WSP(WS_Q1), WSP(WS_K1), WSP(WS_V1), WSP(WS_Q1), a.in[15], a.in[16], vcu);
        } break;
        case 14: ph_outproj(a, lds, WS_Q1, WS_CO, 5); break;
        case 15: ph_ffn_in(a, lds, 3, 5); break;
        case 16: ph_ffn_out<2>(a, lds, 3, 0); break;
        default: break;
        }
        if (ph + 1 < a0.ph_hi) { if (a0.ph_hi > 1000) grid.sync(); else xcd_barrier(bar); }
    }
}
}

extern "C" void kernel_launch(void* const* d_in, const int* in_sizes, int n_in, void* d_out, int out_size, void* d_ws, size_t ws_size, hipStream_t stream) {
    static int grid = 0;
    if (grid == 0) {
        if (n_in != 18 || out_size != mk::M * mk::D || ws_size < mk::WS_END) { fprintf(stderr, "kernel_launch: unexpected shapes n_in %d out %d ws %zu\n", n_in, out_size, ws_size); grid = -1; return; }
        int dev = 0, cus = 0, per_cu = 0;
        (void)hipGetDevice(&dev); (void)hipDeviceGetAttribute(&cus, hipDeviceAttributeMultiprocessorCount, dev);
        (void)hipFuncSetAttribute((const void*)mk::fwd_kernel, hipFuncAttributeMaxDynamicSharedMemorySize, mk::LDS_BYTES);
        (void)hipOccupancyMaxActiveBlocksPerMultiprocessor(&per_cu, (const void*)mk::fwd_kernel, 512, mk::LDS_BYTES);
        (void)hipGetLastError();
        grid = cus > 0 ? cus : 256;
        if (grid > 256) grid = 256;
    }
    if (grid < 0) return;
    mk::Args a{};
    for (int i = 0; i < 18; ++i) a.in[i] = (const float*)d_in[i];
    a.out = (float*)d_out; a.ws = (unsigned char*)d_ws; a.ph_lo = 0; a.ph_hi = mk::N_PHASES;
    (void)hipMemsetAsync((char*)d_ws + mk::WS_CTL, 0, mk::CTL_BYTES, stream);
    void* args[] = {&a};
    hipError_t e = hipLaunchCooperativeKernel((const void*)mk::fwd_kernel, dim3(grid), dim3(512), args, mk::LDS_BYTES, stream);
    if (e != hipSuccess) fprintf(stderr, "cooperative launch failed: %s (grid %d)\n", hipGetErrorString(e), grid);
}
```

```cpp
#include <hip/hip_runtime.h>
#include <hip/hip_cooperative_groups.h>
#include <cstdio>
#include <cstdint>
namespace cg = cooperative_groups;
namespace pg8 {
#define PG8_LAS __attribute__((address_space(3)))
typedef unsigned short bf16_t;
typedef short bf16x8 __attribute__((ext_vector_type(8)));
typedef float f32x4 __attribute__((ext_vector_type(4)));
typedef unsigned u32x4 __attribute__((ext_vector_type(4)));
constexpr int BM = 256, BK = 64, HALF = 128, HTB = HALF * BK * 2  , STAGE_BYTES = 8 * HTB, NXCD = 8, WGM = 8;

__host__ __device__ __forceinline__ int lds_byte(int r, int c) { const int st = (r >> 4) * 2 + (c >> 5), rr = r & 15, cc = c & 31, ob = rr * 64 + cc * 2; return st * 1024 + (ob ^ (((ob >> 9) & 1) << 5)); }
__host__ __device__ __forceinline__ void stage_rc(int b, int& R, int& C) { const int st = b / 1024, sb = b % 1024, swz = sb ^ (((sb >> 9) & 1) << 5); R = (st >> 1) * 16 + swz / 64; C = (st & 1) * 32 + (swz % 64) / 2; }
__host__ __device__ __forceinline__ int perm32(int rho) { const int n = rho >> 4, i = rho & 15; return 8 * (i >> 2) + 4 * n + (i & 3); }

struct Unit { int pm, pn; };
struct Gemm { const bf16_t* A; const bf16_t* Bt; int M, N, K; };

struct StaticOrder {
    int nM, nN, nwg, G, c;
    __host__ __device__ void init(int M, int N, int G_, int c_) { nM = M / BM; nN = N / BM; nwg = nM * nN; G = G_; c = c_; }
    __host__ __device__ bool next(int i, Unit& u) const {
        const long L = (long)i * G + c; if (L >= nwg) return false;
        int wgid = (int)L; { const int q = nwg / NXCD, r = nwg % NXCD, xcd = wgid % NXCD, off = wgid / NXCD; wgid = (xcd < r ? xcd * (q + 1) : r * (q + 1) + (xcd - r) * q) + off; }
        const int nig = WGM * nN, gid = wgid / nig, fm = gid * WGM, gsz = (nM - fm) < WGM ? (nM - fm) : WGM;
        u.pm = fm + ((wgid % nig) % gsz); u.pn = (wgid % nig) / gsz; return true;
    }
    __device__ __forceinline__ void a_ready(const Unit&) const {}
    __device__ __forceinline__ void done(const Unit&) const {}
};

typedef float f32x2cv __attribute__((ext_vector_type(2))); typedef __bf16 bf16x2cv __attribute__((ext_vector_type(2)));
__device__ __forceinline__ unsigned cvt_pk_bf16(float lo, float hi) { f32x2cv v = {lo, hi}; bf16x2cv b = __builtin_convertvector(v, bf16x2cv); return __builtin_bit_cast(unsigned, b); }
typedef float f32x2 __attribute__((ext_vector_type(2)));
template <class Epi, class Sched, bool ALIGN_EPI = false, bool SP2 = false>
__device__ __forceinline__ void gemm_phase(PG8_LAS unsigned char* lds, const Gemm g, const Sched& S, const Epi& E) {
    int tid_ = threadIdx.x; asm volatile("" : "+v"(tid_)); const int tid = tid_, wid = __builtin_amdgcn_readfirstlane(tid >> 6), lane = tid & 63, wr = wid >> 2, wc = wid & 3, fr = lane & 15, fq = lane >> 4;
    const int K = g.K, nt = K / BK;
    unsigned voffA[2], voffB[2];
#pragma unroll
    for (int i = 0; i < 2; ++i) { int R, C; stage_rc(tid * 16 + i * 8192, R, C); const int Rb = Epi::PERM ? ((R & ~31) + perm32(R & 31)) : R;
        voffA[i] = (unsigned)(R * K + C) * 2u; voffB[i] = (unsigned)(Rb * K + C) * 2u; }
    const size_t kstep = (size_t)(BK * 2);
    const size_t hstep = (size_t)HALF * K * 2;
    const size_t tstep = 2 * hstep;
    const unsigned ldsw = (unsigned)wid * 1024u;
    const int aoff = lds_byte(wr * 64 + fr, fq * 8), boff = lds_byte(wc * 32 + fr, fq * 8);
#define PG8_SA(b, h) (((b) * 2 + (h)) * HTB)
#define PG8_SB(b, h) ((4 + (b) * 2 + (h)) * HTB)
#define PG8_STAGE(bufoff, gbase, voff) do { _Pragma("unroll") for (int _i = 0; _i < 2; ++_i) \
        __builtin_amdgcn_global_load_lds((const unsigned*)((const char*)(gbase) + (voff)[_i]), (PG8_LAS unsigned*)(lds + (bufoff) + ldsw + _i * 8192), 16, 0, 0); } while (0)
#define PG8_LDA(dst, b, h) do { _Pragma("unroll") for (int m = 0; m < 4; ++m) _Pragma("unroll") for (int k = 0; k < 2; ++k) dst[m][k] = *(const PG8_LAS bf16x8*)(lds + PG8_SA(b, h) + aoff + m * 2048 + k * 1024); } while (0)
#define PG8_LDB(dst, b, h) do { _Pragma("unroll") for (int n = 0; n < 2; ++n) _Pragma("unroll") for (int k = 0; k < 2; ++k) dst[n][k] = *(const PG8_LAS bf16x8*)(lds + PG8_SB(b, h) + boff + n * 2048 + k * 1024); } while (0)
#define PG8_MMA(ai, bj, At, Bt) do { __builtin_amdgcn_s_setprio(1); _Pragma("unroll") for (int m = 0; m < 4; ++m) _Pragma("unroll") for (int n = 0; n < 2; ++n) _Pragma("unroll") for (int k = 0; k < 2; ++k) \
        acc[ai][bj][m][n] = __builtin_amdgcn_mfma_f32_16x16x32_bf16(Bt[n][k], At[m][k], acc[ai][bj][m][n], 0, 0, 0); __builtin_amdgcn_s_setprio(0); } while (0)
#define PG8_WAIT_V(n) asm volatile("s_waitcnt vmcnt(" #n ")" ::: "memory")
#define PG8_WAIT_L(n) asm volatile("s_waitcnt lgkmcnt(" #n ")" ::: "memory")
#define PG8_BAR __builtin_amdgcn_s_barrier()
#define PG8_SCHED __builtin_amdgcn_sched_barrier(0)
    Unit cur, nxt; int ui = 0;
    if (!S.next(0, cur)) return;
    f32x4 acc[2][2][4][2];
#pragma unroll
    for (int a = 0; a < 2; ++a)
#pragma unroll
        for (int b = 0; b < 2; ++b)
#pragma unroll
            for (int m = 0; m < 4; ++m)
#pragma unroll
                for (int n = 0; n < 2; ++n) acc[a][b][m][n] = (f32x4){0.f, 0.f, 0.f, 0.f};
    bf16x8 At[4][2], B0[2][2], B1[2][2];
    const char* cA = (const char*)g.A + (size_t)cur.pm * tstep; const char* cB = (const char*)g.Bt + (size_t)cur.pn * tstep;
    S.a_ready(cur);
    if constexpr (SP2) {
        PG8_STAGE(PG8_SB(0, 0), cB, voffB); PG8_STAGE(PG8_SB(0, 1), cB + hstep, voffB); PG8_STAGE(PG8_SA(0, 0), cA, voffA); PG8_STAGE(PG8_SA(0, 1), cA + hstep, voffA);
        if (wr == 1) PG8_BAR;
        PG8_WAIT_V(2); PG8_BAR;
        PG8_STAGE(PG8_SB(1, 0), cB + kstep, voffB); PG8_STAGE(PG8_SA(1, 0), cA + kstep, voffA); PG8_STAGE(PG8_SB(1, 1), cB + hstep + kstep, voffB);
        PG8_WAIT_V(6); PG8_BAR;
    } else {
        PG8_STAGE(PG8_SB(0, 0), cB, voffB); PG8_STAGE(PG8_SA(0, 0), cA, voffA); PG8_STAGE(PG8_SB(0, 1), cB + hstep, voffB); PG8_STAGE(PG8_SA(0, 1), cA + hstep, voffA);
        if (wr == 1) PG8_BAR;
        PG8_WAIT_V(4); PG8_BAR;
        PG8_STAGE(PG8_SB(1, 0), cB + kstep, voffB); PG8_STAGE(PG8_SA(1, 0), cA + kstep, voffA); PG8_STAGE(PG8_SB(1, 1), cB + hstep + kstep, voffB);
        PG8_WAIT_V(6); PG8_BAR;
    }
    for (;;) {
        const bool has_next = S.next(ui + 1, nxt);
        const char* nA = has_next ? (const char*)g.A + (size_t)nxt.pm * tstep : cA; const char* nB = has_next ? (const char*)g.Bt + (size_t)nxt.pn * tstep : cB;
        for (int t = 0; t < nt; t += 2) {
            const bool last = (t == nt - 2);
            const char* a1 = cA + (size_t)(t + 1) * kstep;
            const char* a2 = last ? nA : cA + (size_t)(t + 2) * kstep; const char* b2 = last ? nB : cB + (size_t)(t + 2) * kstep;
            const char* a3 = a2 + kstep; const char* b3 = b2 + kstep;
            if (last && has_next) S.a_ready(nxt);
            if constexpr (SP2) {
            PG8_LDB(B0, 0, 0); PG8_LDB(B1, 0, 1); PG8_SCHED; PG8_LDA(At, 0, 0); PG8_STAGE(PG8_SA(1, 1), a1 + hstep, voffA);
            PG8_WAIT_V(8); PG8_WAIT_L(0); PG8_BAR; PG8_MMA(0, 0, At, B0); PG8_MMA(0, 1, At, B1); PG8_BAR; PG8_SCHED;
            PG8_LDA(At, 0, 1); PG8_STAGE(PG8_SB(0, 0), b2, voffB); PG8_STAGE(PG8_SB(0, 1), b2 + hstep, voffB); PG8_STAGE(PG8_SA(0, 0), a2, voffA);
            PG8_WAIT_V(8); PG8_WAIT_L(0); PG8_BAR; PG8_MMA(1, 0, At, B0); PG8_MMA(1, 1, At, B1); PG8_BAR; PG8_SCHED;
            PG8_LDB(B0, 1, 0); PG8_LDB(B1, 1, 1); PG8_SCHED; PG8_LDA(At, 1, 0); PG8_STAGE(PG8_SA(0, 1), a2 + hstep, voffA);
            PG8_WAIT_V(8); PG8_WAIT_L(0); PG8_BAR; PG8_MMA(0, 0, At, B0); PG8_MMA(0, 1, At, B1); PG8_BAR; PG8_SCHED;
            PG8_LDA(At, 1, 1); PG8_STAGE(PG8_SB(1, 0), b3, voffB); PG8_STAGE(PG8_SB(1, 1), b3 + hstep, voffB); PG8_STAGE(PG8_SA(1, 0), a3, voffA);
            PG8_WAIT_V(8); PG8_WAIT_L(0); PG8_BAR; PG8_MMA(1, 0, At, B0); PG8_MMA(1, 1, At, B1); PG8_BAR; PG8_SCHED;
            } else {
            PG8_LDB(B0, 0, 0); PG8_SCHED; PG8_LDA(At, 0, 0); PG8_STAGE(PG8_SA(1, 1), a1 + hstep, voffA);
            PG8_WAIT_L(8); PG8_BAR; PG8_WAIT_L(0); PG8_MMA(0, 0, At, B0); PG8_BAR; PG8_SCHED;
            PG8_LDB(B1, 0, 1); PG8_STAGE(PG8_SB(0, 0), b2, voffB);
            PG8_BAR; PG8_WAIT_L(0); PG8_MMA(0, 1, At, B1); PG8_BAR;
            PG8_LDA(At, 0, 1); PG8_STAGE(PG8_SA(0, 0), a2, voffA);
            PG8_BAR; PG8_WAIT_L(0); PG8_MMA(1, 0, At, B0); PG8_BAR; PG8_SCHED;
            PG8_STAGE(PG8_SB(0, 1), b2 + hstep, voffB);
            PG8_WAIT_V(6); PG8_BAR; PG8_MMA(1, 1, At, B1); PG8_BAR;
            PG8_LDB(B0, 1, 0); PG8_SCHED; PG8_LDA(At, 1, 0); PG8_STAGE(PG8_SA(0, 1), a2 + hstep, voffA);
            PG8_WAIT_L(8); PG8_BAR; PG8_WAIT_L(0); PG8_MMA(0, 0, At, B0); PG8_BAR; PG8_SCHED;
            PG8_LDB(B1, 1, 1); PG8_STAGE(PG8_SB(1, 0), b3, voffB);
            PG8_BAR; PG8_WAIT_L(0); PG8_MMA(0, 1, At, B1); PG8_BAR;
            PG8_LDA(At, 1, 1); PG8_STAGE(PG8_SA(1, 0), a3, voffA);
            PG8_BAR; PG8_WAIT_L(0); PG8_MMA(1, 0, At, B0); PG8_BAR; PG8_SCHED;
            PG8_STAGE(PG8_SB(1, 1), b3 + hstep, voffB);
            PG8_WAIT_V(6); PG8_BAR; PG8_MMA(1, 1, At, B1); PG8_BAR;
            }
        }
        if constexpr (ALIGN_EPI) { if (wr == 0) PG8_BAR; }
        if constexpr (!Epi::AFTER_DRAIN) { E(acc, cur, wr, wc, fr, fq); S.done(cur); }
        if (!has_next) break;
#pragma unroll
        for (int a = 0; a < 2; ++a)
#pragma unroll
            for (int b = 0; b < 2; ++b)
#pragma unroll
                for (int m = 0; m < 4; ++m)
#pragma unroll
                    for (int n = 0; n < 2; ++n) acc[a][b][m][n] = (f32x4){0.f, 0.f, 0.f, 0.f};
        cur = nxt; cA = nA; cB = nB; ++ui;
        if constexpr (ALIGN_EPI) { if (wr == 1) PG8_BAR; }
    }
    PG8_WAIT_V(0);
    if constexpr (!ALIGN_EPI) { if (wr == 0) PG8_BAR; }
    PG8_BAR;
    if constexpr (Epi::AFTER_DRAIN) { E.fused(acc, cur, wr, wc, fr, fq, lds, wid, lane); S.done(cur); }
#undef PG8_SA
#undef PG8_SB
#undef PG8_STAGE
#undef PG8_LDA
#undef PG8_LDB
#undef PG8_MMA
#undef PG8_WAIT_V
#undef PG8_WAIT_L
#undef PG8_BAR
#undef PG8_SCHED
}
}

namespace mk {
using pg8::bf16_t; using pg8::bf16x8; using pg8::f32x4; using pg8::u32x4; using pg8::Unit; using pg8::cvt_pk_bf16;
#define LAS __attribute__((address_space(3)))
typedef LAS unsigned char* ldsp;
typedef float f32x16 __attribute__((ext_vector_type(16)));
typedef short v4i16 __attribute__((ext_vector_type(4)));

constexpr int M = 32768, D = 1024, DFF = 2816, NPROMPT = 16384;
constexpr float EPS = 1e-6f, LOG2E = 1.4426950408889634f;
constexpr float LINIT1 = 0.35550906759096924f;
constexpr int LDS_BYTES = 147456 + 64, LDS_MISC = 147456;

constexpr size_t MiB = 1u << 20;
constexpr size_t WS_TAB0 = 0, WS_TAB1 = 4 * MiB;
constexpr size_t WS_SS = 6 * MiB;
constexpr size_t WS_CTL = 7 * MiB + 768 * 1024, CTL_BYTES = 16384;
constexpr size_t WS_W = 8 * MiB;
constexpr size_t W_FFI = (size_t)5632 * 1024 * 2, W_FFO = (size_t)1024 * 2816 * 2, W_IN = (size_t)3072 * 1024 * 2, W_OUT = (size_t)1024 * 1024 * 2;
constexpr size_t WS_FFI = WS_W, WS_FFO = WS_FFI + 4 * W_FFI, WS_ABI = WS_FFO + 4 * W_FFO, WS_CI = WS_ABI + W_IN, WS_ABO = WS_CI + W_IN, WS_CO = WS_ABO + W_OUT;
constexpr size_t WS_XN = 90 * MiB;
constexpr size_t WS_BIG = 154 * MiB;
constexpr size_t WS_H = WS_BIG;
constexpr size_t WS_QU = WS_BIG, WS_K0 = WS_BIG + 64 * MiB, WS_V0 = WS_BIG + 96 * MiB, WS_SG = WS_BIG + 128 * MiB, WS_U = WS_BIG + 160 * MiB;
constexpr size_t WS_Q1 = WS_BIG, WS_K1 = WS_BIG + 64 * MiB, WS_V1 = WS_BIG + 128 * MiB;
constexpr size_t WS_END = 346 * MiB;
static_assert(WS_CO + W_OUT <= WS_XN, "weights fit");
static_assert(WS_H + (size_t)M * DFF * 2 <= WS_END, "h fits");

#define XB_TMO      128
#define XB_XCNT(j)  (256  + 64 * (j))
#define XB_XSUB(j)  (1280 + 64 * (j))
#define XB_XGEN(j)  (2304 + 64 * (j))
#define XB_TOP      3328
#define XB_TOPGEN   3392
#define XCD_BAR_WORDS 3456
#define XB_SPIN_CAP (1u << 18)

__device__ __forceinline__ unsigned xb_ld(unsigned* p)              { return __hip_atomic_load(p, __ATOMIC_RELAXED, __HIP_MEMORY_SCOPE_AGENT); }
__device__ __forceinline__ unsigned xb_add(unsigned* p, unsigned v) { return __hip_atomic_fetch_add(p, v, __ATOMIC_RELAXED, __HIP_MEMORY_SCOPE_AGENT); }
__device__ __forceinline__ unsigned xb_xcc_id() { return (unsigned)__builtin_amdgcn_s_getreg((3 << 11) | 20) & 0xFu; }
#define XB_SPIN(cond, bar) do { unsigned _sp = 0; while (cond) { __builtin_amdgcn_s_sleep(1); \
    if ((++_sp & 255u) == 0u) { if (xb_ld(&(bar)[XB_TMO])) break; if (_sp > XB_SPIN_CAP) { atomicAdd(&(bar)[XB_TMO], 1u); break; } } } } while (0)

struct XcdBarrier {
    unsigned* bar; unsigned x;
    volatile LAS unsigned* st;
};

__device__ __forceinline__ XcdBarrier xcd_barrier_post(unsigned* bar, volatile LAS unsigned* st) {
    XcdBarrier b; b.bar = bar; b.x = xb_xcc_id(); b.st = st;
    if (threadIdx.x == 0) (void)xb_add(&bar[XB_XCNT(b.x)], 1u);
    return b;
}
__device__ __forceinline__ void xcd_barrier_complete(unsigned* bar, unsigned x, unsigned& nloc, unsigned& nx) {
    const unsigned G = gridDim.x * gridDim.y * gridDim.z;
    unsigned sum, cnt, mine, sp = 0u;
    for (;;) {
        sum = 0u; cnt = 0u; mine = 0u;
#pragma unroll
        for (unsigned j = 0; j < 16; ++j) { const unsigned c = xb_ld(&bar[XB_XCNT(j)]); sum += c; cnt += (c > 0u) ? 1u : 0u; mine = (j == x) ? c : mine; }
        if (sum == G) break;
        __builtin_amdgcn_s_sleep(1);
        if ((++sp & 255u) == 0u) { if (xb_ld(&bar[XB_TMO])) break; if (sp > XB_SPIN_CAP) { atomicAdd(&bar[XB_TMO], 1u); break; } }
    }
    nloc = mine > 0u ? mine : 1u; nx = cnt > 0u ? cnt : 1u;
}

__device__ __forceinline__ void xcd_barrier(const XcdBarrier& b) {
    asm volatile("s_waitcnt vmcnt(0)" ::: "memory");
    __syncthreads();
    if (threadIdx.x == 0) {
        unsigned* bar = b.bar;
        __builtin_amdgcn_s_waitcnt(0);
        unsigned nloc = b.st[0], nx = b.st[1];
        if (nloc == 0u) { xcd_barrier_complete(bar, b.x, nloc, nx); b.st[0] = nloc; b.st[1] = nx; }
        const unsigned old = xb_add(&bar[XB_XSUB(b.x)], 1u);
        const unsigned gen = old / nloc;
        if (old + 1u == (gen + 1u) * nloc) {
            __builtin_amdgcn_fence(__ATOMIC_RELEASE, "agent");
            asm volatile("s_waitcnt vmcnt(0)" ::: "memory");
            const unsigned og = xb_add(&bar[XB_TOP], 1u);
            const unsigned tg = og / nx;
            if (og + 1u == (tg + 1u) * nx) xb_add(&bar[XB_TOPGEN], 1u);
            else XB_SPIN(xb_ld(&bar[XB_TOPGEN]) == tg, bar);
            __builtin_amdgcn_fence(__ATOMIC_ACQUIRE, "agent");
            xb_add(&bar[XB_XGEN(b.x)], 1u);
            asm volatile("s_waitcnt vmcnt(0)" ::: "memory");
        } else {
            XB_SPIN(xb_ld(&bar[XB_XGEN(b.x)]) == gen, bar);
            __builtin_amdgcn_fence(__ATOMIC_ACQUIRE, "agent");
            asm volatile("s_waitcnt vmcnt(0)" ::: "memory");
        }
    }
    __syncthreads();
}

__device__ __forceinline__ float bf2f(unsigned short b) { return __uint_as_float(((unsigned)b) << 16); }
__device__ __forceinline__ float bflo(unsigned w) { return __uint_as_float(w << 16); }
__device__ __forceinline__ float bfhi(unsigned w) { return __uint_as_float(w & 0xffff0000u); }
__device__ __forceinline__ unsigned short f2bf(float f) { return (unsigned short)(cvt_pk_bf16(f, 0.f) & 0xffffu); }
__device__ __forceinline__ float ssf(unsigned long long v) { return (float)v * (1.f / 1048576.f); }
__device__ __forceinline__ float ex2(float x) { return __builtin_amdgcn_exp2f(x); }
__device__ __forceinline__ float sigmoidf_(float x) { return __builtin_amdgcn_rcpf(1.f + ex2(-x * LOG2E)); }
__device__ __forceinline__ float siluf_(float x) { return x * sigmoidf_(x); }
__device__ __forceinline__ float wave_sum(float v) {
#pragma unroll
    for (int o = 1; o < 64; o <<= 1) v += __shfl_xor(v, o);
    return v;
}
__device__ __forceinline__ float wave_max(float v) {
#pragma unroll
    for (int o = 1; o < 64; o <<= 1) v = fmaxf(v, __shfl_xor(v, o));
    return v;
}
__device__ __forceinline__ float sum32(float v) {
#pragma unroll
    for (int o = 1; o < 32; o <<= 1) v += __shfl_xor(v, o);
    return v;
}
__device__ __forceinline__ int otid() { int t = threadIdx.x; asm volatile("" : "+v"(t)); return t; }
__device__ __forceinline__ int obx() { int b = blockIdx.x; asm volatile("" : "+s"(b)); return b; }
__device__ __forceinline__ int pos_of_row(int row) { return row < NPROMPT ? (row & 4095) : (row & 8191); }
__device__ __forceinline__ int crow(int r, int hi) { return (r & 3) + 8 * (r >> 2) + 4 * hi; }
__device__ __forceinline__ f32x16 mfma32(bf16x8 a, bf16x8 b, f32x16 c) { return __builtin_amdgcn_mfma_f32_32x32x16_bf16(a, b, c, 0, 0, 0); }
__device__ __forceinline__ v4i16 trrd(ldsp p) { return __builtin_amdgcn_ds_read_tr16_b64_v4i16((LAS v4i16*)p); }
__device__ __forceinline__ bf16x8 tr_frag(ldsp p, int off2) { const v4i16 a = trrd(p), b = trrd(p + off2); return (bf16x8){a[0], a[1], a[2], a[3], b[0], b[1], b[2], b[3]}; }
__device__ __forceinline__ bf16x8 pack8(float a, float b, float c, float d, float e, float f, float g, float h) {
    u32x4 w; w.x = cvt_pk_bf16(a, b); w.y = cvt_pk_bf16(c, d); w.z = cvt_pk_bf16(e, f); w.w = cvt_pk_bf16(g, h); return __builtin_bit_cast(bf16x8, w);
}

typedef float f32x2p __attribute__((ext_vector_type(2)));
__device__ __forceinline__ f32x2p swiglu2(f32x2p g, f32x2p u, float kneg, float r2) {
    const f32x2p t = g * kneg;
    f32x2p e; e.x = ex2(t.x); e.y = ex2(t.y);
    const f32x2p d = e + 1.0f;
    f32x2p r; r.x = __builtin_amdgcn_rcpf(d.x); r.y = __builtin_amdgcn_rcpf(d.y);
    return (g * u) * (r * r2);
}
struct EpiSwiglu {
    static constexpr bool PERM = true, AFTER_DRAIN = false; bf16_t* H; const unsigned long long* ss;
    __device__ __forceinline__ void operator()(const f32x4 (&acc)[2][2][4][2], const Unit& u, int wr, int wc, int fr, int fq) const {
        const int row0 = u.pm * 256 + wr * 64 + fr, col0 = u.pn * 128 + wc * 32 + 8 * fq;
#pragma unroll
        for (int ai = 0; ai < 2; ++ai)
#pragma unroll
            for (int m = 0; m < 4; ++m) {
                bf16_t* rp = H + (size_t)(row0 + ai * 128 + m * 16) * DFF + col0;
                const float rstd = __builtin_amdgcn_rsqf(ssf(ss[row0 + ai * 128 + m * 16]) * (1.f / D) + EPS);
                const float kneg = -rstd * LOG2E, r2 = rstd * rstd;
                const f32x4 g0 = acc[ai][0][m][0], g1 = acc[ai][0][m][1], u0 = acc[ai][1][m][0], u1 = acc[ai][1][m][1];
                const f32x2p a = swiglu2((f32x2p){g0[0], g0[1]}, (f32x2p){u0[0], u0[1]}, kneg, r2), b = swiglu2((f32x2p){g0[2], g0[3]}, (f32x2p){u0[2], u0[3]}, kneg, r2);
                const f32x2p c = swiglu2((f32x2p){g1[0], g1[1]}, (f32x2p){u1[0], u1[1]}, kneg, r2), d = swiglu2((f32x2p){g1[2], g1[3]}, (f32x2p){u1[2], u1[3]}, kneg, r2);
                u32x4 w; w.x = cvt_pk_bf16(a.x, a.y); w.y = cvt_pk_bf16(b.x, b.y); w.z = cvt_pk_bf16(c.x, c.y); w.w = cvt_pk_bf16(d.x, d.y);
                *(u32x4*)rp = w;
                asm volatile("" ::: "memory");
            }
    }
};
__device__ __forceinline__ void store8(bf16_t* p, const float (&v)[8]) {
    u32x4 w; w.x = cvt_pk_bf16(v[0], v[1]); w.y = cvt_pk_bf16(v[2], v[3]); w.z = cvt_pk_bf16(v[4], v[5]); w.w = cvt_pk_bf16(v[6], v[7]); *(u32x4*)p = w;
}
template <int MODE> struct EpiResid {
    static constexpr bool PERM = true, AFTER_DRAIN = false; const float* baseA; const float* baseB; float* out; float scale; bf16_t* XB; unsigned long long* ss;
    __device__ __forceinline__ void operator()(const f32x4 (&acc)[2][2][4][2], const Unit& u, int wr, int wc, int fr, int fq) const {
        const int row0 = u.pm * 256 + wr * 64 + fr, col0 = u.pn * 256 + wc * 32 + 8 * fq;
        const float* bp = (u.pm < 64) ? baseA + (size_t)row0 * D : baseB + (size_t)(row0 - NPROMPT) * D;
        float* op = out + (size_t)row0 * D;
        bf16_t* xp = XB + (size_t)row0 * D;
#pragma unroll
        for (int ai = 0; ai < 2; ++ai)
#pragma unroll
            for (int m = 0; m < 4; ++m) {
                const size_t ro = (size_t)(ai * 128 + m * 16) * D + col0;
                float sq = 0.f;
#pragma unroll
                for (int bj = 0; bj < 2; ++bj) {
                    f32x4 b0, b1;
                    if (MODE == 0) { b0 = *(const f32x4*)(bp + ro + bj * 128); b1 = *(const f32x4*)(bp + ro + bj * 128 + 4); }
                    else { const u32x4 w = *(const u32x4*)(xp + ro + bj * 128);
                        b0 = (f32x4){bflo(w.x), bfhi(w.x), bflo(w.y), bfhi(w.y)}; b1 = (f32x4){bflo(w.z), bfhi(w.z), bflo(w.w), bfhi(w.w)}; }
                    const f32x4 y0 = b0 + acc[ai][bj][m][0] * scale, y1 = b1 + acc[ai][bj][m][1] * scale;
                    if (MODE == 2) { *(f32x4*)(op + ro + bj * 128) = y0; *(f32x4*)(op + ro + bj * 128 + 4) = y1; }
                    else {
                        u32x4 w; w.x = cvt_pk_bf16(y0[0], y0[1]); w.y = cvt_pk_bf16(y0[2], y0[3]); w.z = cvt_pk_bf16(y1[0], y1[1]); w.w = cvt_pk_bf16(y1[2], y1[3]);
                        *(u32x4*)(xp + ro + bj * 128) = w;
                        sq += (y0[0] * y0[0] + y0[1] * y0[1]) + (y0[2] * y0[2] + y0[3] * y0[3]) + (y1[0] * y1[0] + y1[1] * y1[1]) + (y1[2] * y1[2] + y1[3] * y1[3]);
                    }
                }
                if (MODE != 2) { sq += __shfl_xor(sq, 16); sq += __shfl_xor(sq, 32); if (fq == 0) atomicAdd(ss + row0 + ai * 128 + m * 16, (unsigned long long)(sq * 1048576.f + 0.5f)); }
                asm volatile("" ::: "memory");
            }
    }
};
template <int KIND> struct EpiAB {
    static constexpr bool PERM = true, AFTER_DRAIN = false;
    bf16_t *QU, *K0, *V0, *SG, *U; const float* tab0; const unsigned long long* ss;
    __device__ __forceinline__ void operator()(const f32x4 (&acc)[2][2][4][2], const Unit& u, int wr, int wc, int fr, int fq) const {
        const int pn = u.pn + 4 * KIND, rowb = u.pm * 256 + wr * 64 + fr;
        if constexpr (KIND == 0) {
            const int head = 2 * (pn & 1) + (wc >> 1), i0 = 32 * (wc & 1) + 8 * fq;
            bf16_t* dst = pn < 2 ? QU : K0; const int ld = pn < 2 ? 1024 : 512; const float sc = pn < 2 ? 1.f : 0.08838834764831845f;
#pragma unroll
            for (int ai = 0; ai < 2; ++ai)
#pragma unroll
                for (int m = 0; m < 4; ++m) {
                    const int row = rowb + ai * 128 + m * 16, s = pos_of_row(row);
                    const float rs = __builtin_amdgcn_rsqf(ssf(ss[row]) * (1.f / D) + EPS) * sc;
                    const f32x4* tp = (const f32x4*)(tab0 + ((size_t)s * 64 + i0) * 2);
                    float o1[8], o2[8];
#pragma unroll
                    for (int n = 0; n < 2; ++n) {
                        const f32x4 ta = tp[2 * n], tb = tp[2 * n + 1]; const f32x4 x1 = acc[ai][0][m][n] * rs, x2 = acc[ai][1][m][n] * rs;
                        o1[4 * n + 0] = x1[0] * ta[0] - x2[0] * ta[1]; o2[4 * n + 0] = x2[0] * ta[0] + x1[0] * ta[1];
                        o1[4 * n + 1] = x1[1] * ta[2] - x2[1] * ta[3]; o2[4 * n + 1] = x2[1] * ta[2] + x1[1] * ta[3];
                        o1[4 * n + 2] = x1[2] * tb[0] - x2[2] * tb[1]; o2[4 * n + 2] = x2[2] * tb[0] + x1[2] * tb[1];
                        o1[4 * n + 3] = x1[3] * tb[2] - x2[3] * tb[3]; o2[4 * n + 3] = x2[3] * tb[2] + x1[3] * tb[3];
                    }
                    bf16_t* rp = dst + (size_t)row * ld + 128 * head + i0;
                    store8(rp, o1); store8(rp + 64, o2); asm volatile("" ::: "memory");
                }
        } else if constexpr (KIND == 1) {
            bf16_t* dst = pn < 6 ? V0 : SG; const bool act = pn >= 6; const int col0 = 256 * (pn & 1) + wc * 32 + 8 * fq;
#pragma unroll
            for (int ai = 0; ai < 2; ++ai)
#pragma unroll
                for (int m = 0; m < 4; ++m) {
                    const int row = rowb + ai * 128 + m * 16;
                    const float rs = __builtin_amdgcn_rsqf(ssf(ss[row]) * (1.f / D) + EPS);
#pragma unroll
                    for (int bj = 0; bj < 2; ++bj) {
                        float v[8];
#pragma unroll
                        for (int n = 0; n < 2; ++n)
#pragma unroll
                            for (int j = 0; j < 4; ++j) { const float x = acc[ai][bj][m][n][j] * rs; v[4 * n + j] = act ? siluf_(x) : x; }
                        store8(dst + (size_t)row * 512 + col0 + 128 * bj, v);
                    }
                    asm volatile("" ::: "memory");
                }
        } else {
            const int col0 = 128 * (pn - 8) + wc * 32 + 8 * fq;
#pragma unroll
            for (int ai = 0; ai < 2; ++ai)
#pragma unroll
                for (int m = 0; m < 4; ++m) {
                    const int row = rowb + ai * 128 + m * 16;
                    const float rs = __builtin_amdgcn_rsqf(ssf(ss[row]) * (1.f / D) + EPS);
                    float v[8];
#pragma unroll
                    for (int n = 0; n < 2; ++n)
#pragma unroll
                        for (int j = 0; j < 4; ++j) v[4 * n + j] = acc[ai][0][m][n][j] * rs * sigmoidf_(acc[ai][1][m][n][j] * rs);
                    store8(U + (size_t)row * 512 + col0, v); asm volatile("" ::: "memory");
                }
        }
    }
};
struct EpiABAll {
    static constexpr bool PERM = true, AFTER_DRAIN = false;
    bf16_t *QU, *K0, *V0, *SG, *U; const float* tab0; const unsigned long long* ss;
    __device__ __forceinline__ void operator()(const f32x4 (&acc)[2][2][4][2], const Unit& u, int wr, int wc, int fr, int fq) const {
        Unit v = u;
        if (u.pn < 4) { EpiAB<0>{QU, K0, V0, SG, U, tab0, ss}(acc, v, wr, wc, fr, fq); }
        else if (u.pn < 8) { v.pn = u.pn - 4; EpiAB<1>{QU, K0, V0, SG, U, tab0, ss}(acc, v, wr, wc, fr, fq); }
        else { v.pn = u.pn - 8; EpiAB<2>{QU, K0, V0, SG, U, tab0, ss}(acc, v, wr, wc, fr, fq); }
    }
};
struct EpiC {
    static constexpr bool PERM = true, AFTER_DRAIN = false;
    bf16_t *Q1, *K1, *V1; const float* tab1; const float* qg; const float* kg; const unsigned long long* ss;
    __device__ __forceinline__ void operator()(const f32x4 (&acc)[2][2][4][2], const Unit& u, int wr, int wc, int fr, int fq) const {
        const int pn = u.pn, rowb = u.pm * 256 + wr * 64 + fr;
        if (pn < 8) {
            const int group = 4 * (pn & 3) + wc, i0 = 8 * fq;
            bf16_t* dst = pn < 4 ? Q1 : K1; const float* gp = pn < 4 ? qg : kg; const float sc = pn < 4 ? 0.125f * LOG2E : 1.f;
            float g1[8], g2[8];
#pragma unroll
            for (int j = 0; j < 8; ++j) { g1[j] = gp[i0 + j] * sc; g2[j] = gp[32 + i0 + j] * sc; }
#pragma unroll
            for (int ai = 0; ai < 2; ++ai)
#pragma unroll
                for (int m = 0; m < 4; ++m) {
                    const int row = rowb + ai * 128 + m * 16, s = pos_of_row(row);
                    const float rs0 = __builtin_amdgcn_rsqf(ssf(ss[row]) * (1.f / D) + EPS);
                    float sq = 0.f;
#pragma unroll
                    for (int bj = 0; bj < 2; ++bj)
#pragma unroll
                        for (int n = 0; n < 2; ++n) { const f32x4 x = acc[ai][bj][m][n] * rs0; sq += (x[0] * x[0] + x[1] * x[1]) + (x[2] * x[2] + x[3] * x[3]); }
                    sq += __shfl_xor(sq, 16); sq += __shfl_xor(sq, 32);
                    const float rstd = __builtin_amdgcn_rsqf(sq * (1.f / 64.f) + EPS) * rs0;
                    const f32x4* tp = (const f32x4*)(tab1 + ((size_t)s * 32 + i0) * 2);
                    float o1[8], o2[8];
#pragma unroll
                    for (int n = 0; n < 2; ++n) {
                        const f32x4 ta = tp[2 * n], tb = tp[2 * n + 1]; f32x4 x1 = acc[ai][0][m][n] * rstd, x2 = acc[ai][1][m][n] * rstd;
#pragma unroll
                        for (int j = 0; j < 4; ++j) { x1[j] *= g1[4 * n + j]; x2[j] *= g2[4 * n + j]; }
                        o1[4 * n + 0] = x1[0] * ta[0] - x2[0] * ta[1]; o2[4 * n + 0] = x2[0] * ta[0] + x1[0] * ta[1];
                        o1[4 * n + 1] = x1[1] * ta[2] - x2[1] * ta[3]; o2[4 * n + 1] = x2[1] * ta[2] + x1[1] * ta[3];
                        o1[4 * n + 2] = x1[2] * tb[0] - x2[2] * tb[1]; o2[4 * n + 2] = x2[2] * tb[0] + x1[2] * tb[1];
                        o1[4 * n + 3] = x1[3] * tb[2] - x2[3] * tb[3]; o2[4 * n + 3] = x2[3] * tb[2] + x1[3] * tb[3];
                    }
                    bf16_t* rp = dst + (size_t)row * 1024 + 64 * group + i0;
                    store8(rp, o1); store8(rp + 32, o2); asm volatile("" ::: "memory");
                }
        } else {
            const int col0 = 256 * (pn - 8) + wc * 32 + 8 * fq;
#pragma unroll
            for (int ai = 0; ai < 2; ++ai)
#pragma unroll
                for (int m = 0; m < 4; ++m) {
                    const int row = rowb + ai * 128 + m * 16;
                    const float rs = __builtin_amdgcn_rsqf(ssf(ss[row]) * (1.f / D) + EPS);
#pragma unroll
                    for (int bj = 0; bj < 2; ++bj) {
                        float v[8];
#pragma unroll
                        for (int n = 0; n < 2; ++n)
#pragma unroll
                            for (int j = 0; j < 4; ++j) v[4 * n + j] = acc[ai][bj][m][n][j] * rs;
                        store8(V1 + (size_t)row * 1024 + col0 + 128 * bj, v);
                    }
                    asm volatile("" ::: "memory");
                }
        }
    }
};

__device__ __forceinline__ int perm_col(int ptype, int np) {
    const int pn = np >> 8, bj = (np >> 7) & 1, t = np & 127;
    if (ptype == 1) return bj * DFF + 128 * pn + t;
    if (ptype == 2) {
        if (pn < 4) { const int base = (pn < 2) ? 0 : 512, pl = pn & 1; return base + 256 * pl + 128 * (t >> 6) + 64 * bj + (t & 63); }
        if (pn < 8) return np;
        return 2048 + 512 * bj + 128 * (pn - 8) + t;
    }
    if (ptype == 3) {
        if (pn < 8) { const int base = (pn < 4) ? 0 : 1024, pl = pn & 3; return base + 64 * (4 * pl + (t >> 5)) + 32 * bj + (t & 31); }
        return np;
    }
    return np;
}
__device__ __forceinline__ void transpose_item(const float* W, int K, int N, int ptype, bf16_t* WT, LAS float* scr, int item, int lane, const float* gain) {
    const int nblk = N / 32, kb = item / nblk, nb = item % nblk, k0 = 64 * kb, n0 = perm_col(ptype, 32 * nb);
    float wv[32];
#pragma unroll
    for (int i = 0; i < 32; ++i) { const int kk = 2 * i + (lane >> 5); wv[i] = W[(size_t)(k0 + kk) * N + n0 + (lane & 31)]; }
    const float g0 = gain ? gain[k0 + (lane >> 5) + 2 * (lane & 31)] : 1.f;
#pragma unroll
    for (int i = 0; i < 32; ++i) { const int kk = 2 * i + (lane >> 5); scr[kk * 33 + (lane & 31)] = wv[i] * __shfl(g0, i + (lane & 32)); }
    asm volatile("s_waitcnt lgkmcnt(0)" ::: "memory");
    const int c = lane & 7;
#pragma unroll
    for (int j = 0; j < 4; ++j) { const int n = (lane >> 3) + 8 * j; const LAS float* s = scr + (8 * c) * 33 + n;
        u32x4 o; o.x = cvt_pk_bf16(s[0 * 33], s[1 * 33]); o.y = cvt_pk_bf16(s[2 * 33], s[3 * 33]); o.z = cvt_pk_bf16(s[4 * 33], s[5 * 33]); o.w = cvt_pk_bf16(s[6 * 33], s[7 * 33]);
        *(u32x4*)(WT + (size_t)(32 * nb + n) * K + k0 + 8 * c) = o; }
    asm volatile("s_waitcnt lgkmcnt(0)" ::: "memory");
}
__device__ __forceinline__ void rms_row_to_bf16(const float* xrow, float* ssrow, bf16_t* orow, int lane) {
    const f32x4* xr = (const f32x4*)xrow + lane;
    f32x4 v[4]; float s = 0.f;
#pragma unroll
    for (int j = 0; j < 4; ++j) { v[j] = xr[64 * j]; s += (v[j][0] * v[j][0] + v[j][1] * v[j][1]) + (v[j][2] * v[j][2] + v[j][3] * v[j][3]); }
    const float tot = wave_sum(s);
    if (lane == 0) *ssrow = tot;
    unsigned long long* o8 = (unsigned long long*)orow + lane;
#pragma unroll
    for (int j = 0; j < 4; ++j) { const f32x4 y = v[j];
        o8[64 * j] = (unsigned long long)cvt_pk_bf16(y[0], y[1]) | ((unsigned long long)cvt_pk_bf16(y[2], y[3]) << 32); }
}
__device__ __forceinline__ void norm_phase(const float* xA, const float* xB, unsigned long long* ss, bf16_t* XN, int gw, int lane) {
    for (int m0 = gw; m0 < M; m0 += 4 * 2048) {
        f32x4 v[4][4];
#pragma unroll
        for (int q = 0; q < 4; ++q) { const int m = m0 + 2048 * q; const float* xr = m < NPROMPT ? xA + (size_t)m * D : xB + (size_t)(m - NPROMPT) * D;
#pragma unroll
            for (int j = 0; j < 4; ++j) v[q][j] = ((const f32x4*)xr + lane)[64 * j]; }
#pragma unroll
        for (int q = 0; q < 4; ++q) { const int m = m0 + 2048 * q; float s = 0.f;
#pragma unroll
            for (int j = 0; j < 4; ++j) s += (v[q][j][0] * v[q][j][0] + v[q][j][1] * v[q][j][1]) + (v[q][j][2] * v[q][j][2] + v[q][j][3] * v[q][j][3]);
            const float tot = wave_sum(s);
            if (lane == 0) ss[m] = (unsigned long long)(tot * 1048576.f + 0.5f);
            unsigned long long* o8 = (unsigned long long*)(XN + (size_t)m * D) + lane;
#pragma unroll
            for (int j = 0; j < 4; ++j) o8[64 * j] = (unsigned long long)cvt_pk_bf16(v[q][j][0], v[q][j][1]) | ((unsigned long long)cvt_pk_bf16(v[q][j][2], v[q][j][3]) << 32); }
    }
}
__device__ __forceinline__ void rope_entry(float* tab, int half, int idx) {
    const int s = idx / half, i = idx % half;
    const float inv = exp2f(-(float)i / (float)half * 13.287712379549449f);
    const float ang = (float)s * inv;
    const double a = (double)ang;
    const double k = rint(a * 0.15915494309189535);
    double r = fma(-k, 6.283185307179586, a); r = fma(-k, 2.4492935982947064e-16, r);
    const float rf = (float)r;
    tab[2 * (size_t)idx] = cosf(rf); tab[2 * (size_t)idx + 1] = sinf(rf);
}

__device__ __forceinline__ void r1_unit(ldsp lds, int uidx, const bf16_t* K0, const bf16_t* V0, bf16_t* KV, float lgf2, float lgb2) {
    const int tid = otid(), lane = tid & 63, wid = __builtin_amdgcn_readfirstlane(tid >> 6), r32 = lane & 31, hi = lane >> 5;
    const int gc = uidx >> 2, h = uidx & 3, r0 = gc * 128;
    ldsp Kimg = lds, Vf = lds + 40960, Vb = lds + 81920;
#pragma unroll
    for (int i = 0; i < 4; ++i) {
        const int cidx = tid + 512 * i, key = cidx >> 4, ch = cidx & 15;
        const u32x4 kv = *(const u32x4*)(K0 + (size_t)(r0 + key) * 512 + 128 * h + 8 * ch);
        const u32x4 vv = *(const u32x4*)(V0 + (size_t)(r0 + key) * 512 + 128 * h + 8 * ch);
        *(LAS u32x4*)(Kimg + key * 320 + ch * 16) = kv;
        const float df = ex2(lgf2 * (float)(127 - key)), db = ex2(lgb2 * (float)key);
        u32x4 wf, wb;
        wf.x = cvt_pk_bf16(bflo(vv.x) * df, bfhi(vv.x) * df); wf.y = cvt_pk_bf16(bflo(vv.y) * df, bfhi(vv.y) * df);
        wf.z = cvt_pk_bf16(bflo(vv.z) * df, bfhi(vv.z) * df); wf.w = cvt_pk_bf16(bflo(vv.w) * df, bfhi(vv.w) * df);
        wb.x = cvt_pk_bf16(bflo(vv.x) * db, bfhi(vv.x) * db); wb.y = cvt_pk_bf16(bflo(vv.y) * db, bfhi(vv.y) * db);
        wb.z = cvt_pk_bf16(bflo(vv.z) * db, bfhi(vv.z) * db); wb.w = cvt_pk_bf16(bflo(vv.w) * db, bfhi(vv.w) * db);
        *(LAS u32x4*)(Vf + key * 320 + ch * 16) = wf;
        *(LAS u32x4*)(Vb + key * 320 + ch * 16) = wb;
    }
    __syncthreads();
    const int dir = wid >> 2, dblk = wid & 3;
    ldsp Vimg = dir ? Vb : Vf;
    const int trow = (lane & 15) >> 2, tcol = 16 * ((lane >> 4) & 1) + 4 * (lane & 3);
    f32x16 acc[4];
#pragma unroll
    for (int eb = 0; eb < 4; ++eb)
#pragma unroll
        for (int r = 0; r < 16; ++r) acc[eb][r] = 0.f;
#pragma unroll
    for (int s = 0; s < 8; ++s) {
        const int krow = 16 * s + 8 * hi + trow;
        const bf16x8 af = tr_frag(Kimg + krow * 320 + (32 * dblk + tcol) * 2, 4 * 320);
#pragma unroll
        for (int eb = 0; eb < 4; ++eb) {
            const bf16x8 bfr = tr_frag(Vimg + krow * 320 + (32 * eb + tcol) * 2, 4 * 320);
            acc[eb] = mfma32(af, bfr, acc[eb]);
        }
    }
    bf16_t* op = KV + (size_t)(uidx * 2 + dir) * 16384 + (size_t)(32 * dblk) * 128;
    __syncthreads();
    ldsp st = lds + wid * 8704;
#pragma unroll
    for (int eb = 0; eb < 4; ++eb)
#pragma unroll
        for (int r = 0; r < 16; ++r) ((LAS unsigned short*)(st + crow(r, hi) * 272))[32 * eb + r32] = f2bf(acc[eb][r]);
    asm volatile("s_waitcnt lgkmcnt(0)" ::: "memory");
#pragma unroll
    for (int i = 0; i < 8; ++i) { const int idx = lane + 64 * i, row = idx >> 4, ch = idx & 15;
        *(u32x4*)(op + row * 128 + 8 * ch) = *(const LAS u32x4*)(st + row * 272 + ch * 16); }
    __syncthreads();
}
__device__ __forceinline__ void conv_tile(ldsp lds, int tile, const bf16_t* U, const float* cw, const float* cb, const float* cg, bf16_t* QU) {
    const int tid = otid(), lane = tid & 63, wid = __builtin_amdgcn_readfirstlane(tid >> 6);
    const int t0 = tile * 32;
    const int seq_lo = t0 < NPROMPT ? (t0 & ~4095) : (t0 & ~8191), seq_hi = seq_lo + (t0 < NPROMPT ? 4096 : 8192);
    LAS unsigned short* Ut = (LAS unsigned short*)lds;
    LAS float* Y = (LAS float*)(lds + 65536);
    LAS float* part = (LAS float*)(lds + 65536 + 65536);
    for (int cidx = tid; cidx < 62 * 64; cidx += 512) {
        const int rr = cidx >> 6, ch = cidx & 63, grow = t0 - 15 + rr;
        u32x4 v = (u32x4){0u, 0u, 0u, 0u};
        if (grow >= seq_lo && grow < seq_hi) v = *(const u32x4*)(U + (size_t)grow * 512 + 8 * ch);
        *(LAS u32x4*)(lds + rr * 1024 + ch * 16) = v;
    }
    float w[31];
#pragma unroll
    for (int k = 0; k < 31; ++k) w[k] = cw[k * 512 + tid];
    const float bias = cb[tid], gain = cg[tid];
    __syncthreads();
    float xin[62];
#pragma unroll
    for (int k = 0; k < 62; ++k) xin[k] = bf2f(Ut[k * 512 + tid]);
#pragma unroll
    for (int tt = 0; tt < 32; ++tt) {
        float y = bias;
#pragma unroll
        for (int k = 0; k < 31; ++k) y += xin[tt + k] * w[k];
        Y[tt * 512 + tid] = y;
        const float s = wave_sum(y * y);
        if (lane == 0) part[wid * 32 + tt] = s;
    }
    __syncthreads();
    for (int tt = 0; tt < 32; ++tt) {
        float ss = 0.f;
#pragma unroll
        for (int k = 0; k < 8; ++k) ss += part[k * 32 + tt];
        const float rstd = __builtin_amdgcn_rsqf(ss * (1.f / 512.f) + EPS);
        const float v = Y[tt * 512 + tid] * rstd * gain;
        QU[(size_t)(t0 + tt) * 1024 + 512 + tid] = f2bf(siluf_(v));
    }
    __syncthreads();
}
__device__ __forceinline__ void scan_phase(bf16_t* KV, const float* decay, int gtid) {
    if (gtid >= 98304) return;
    const int v = gtid & 2047, rest = gtid >> 11, dir = rest & 1, h = (rest >> 1) & 3, seq = rest >> 3;
    const int nc = seq < 4 ? 32 : 64, gc0 = seq < 4 ? seq * 32 : 128 + (seq - 4) * 64;
    const float lg = -expf(decay[dir * 4 + h]);
    const float cd = expf(lg * 128.f);
    float st[8];
#pragma unroll
    for (int j = 0; j < 8; ++j) st[j] = 0.f;
    for (int b = 0; b < nc; b += 8) {
        u32x4 buf[8];
#pragma unroll
        for (int i = 0; i < 8; ++i) { const int lc = dir ? (nc - 1 - (b + i)) : (b + i);
            buf[i] = *(const u32x4*)(KV + ((size_t)((gc0 + lc) * 4 + h) * 2 + dir) * 16384 + v * 8); }
#pragma unroll
        for (int i = 0; i < 8; ++i) { const int lc = dir ? (nc - 1 - (b + i)) : (b + i);
            u32x4 o; o.x = cvt_pk_bf16(st[0], st[1]); o.y = cvt_pk_bf16(st[2], st[3]); o.z = cvt_pk_bf16(st[4], st[5]); o.w = cvt_pk_bf16(st[6], st[7]);
            *(u32x4*)(KV + ((size_t)((gc0 + lc) * 4 + h) * 2 + dir) * 16384 + v * 8) = o;
            st[0] = st[0] * cd + bflo(buf[i].x); st[1] = st[1] * cd + bfhi(buf[i].x); st[2] = st[2] * cd + bflo(buf[i].y); st[3] = st[3] * cd + bfhi(buf[i].y);
            st[4] = st[4] * cd + bflo(buf[i].z); st[5] = st[5] * cd + bfhi(buf[i].z); st[6] = st[6] * cd + bflo(buf[i].w); st[7] = st[7] * cd + bfhi(buf[i].w); }
    }
}
__device__ __forceinline__ void r3_unit(ldsp lds, int uidx, bf16_t* QU, const bf16_t* K0, const bf16_t* V0, const bf16_t* SG, const bf16_t* KV, const float* retg, float lgf2, float lgb2) {
    const int tid = otid(), lane = tid & 63, wid = __builtin_amdgcn_readfirstlane(tid >> 6), r32 = lane & 31, hi = lane >> 5;
    const int gc = uidx >> 2, h = uidx & 3, r0 = gc * 128;
    const int qb = wid & 3, eh = wid >> 2;
    ldsp bufA = lds, bufB = lds + 34816, bufC = lds + 75776; LAS float* ssx = (LAS float*)(lds + 116736);
    bf16x8 qf[8];
    { const bf16_t* qp = QU + (size_t)(r0 + 32 * qb + r32) * 1024 + 128 * h + 8 * hi;
#pragma unroll
      for (int s = 0; s < 8; ++s) qf[s] = *(const bf16x8*)(qp + 16 * s); }
#pragma unroll
    for (int i = 0; i < 4; ++i) {
        const int cidx = tid + 512 * i, key = cidx >> 4, ch = cidx & 15;
        *(LAS u32x4*)(bufA + key * 272 + ch * 16) = *(const u32x4*)(K0 + (size_t)(r0 + key) * 512 + 128 * h + 8 * ch);
        *(LAS u32x4*)(bufB + key * 320 + ch * 16) = *(const u32x4*)(KV + (size_t)(uidx * 2 + 0) * 16384 + key * 128 + 8 * ch);
        *(LAS u32x4*)(bufC + key * 320 + ch * 16) = *(const u32x4*)(KV + (size_t)(uidx * 2 + 1) * 16384 + key * 128 + 8 * ch);
    }
    __syncthreads();
    const int trow = (lane & 15) >> 2, tcol = 16 * ((lane >> 4) & 1) + 4 * (lane & 3);
    f32x16 ot[2];
    {
        f32x16 af[2], ab[2];
#pragma unroll
        for (int e2 = 0; e2 < 2; ++e2)
#pragma unroll
            for (int r = 0; r < 16; ++r) { af[e2][r] = 0.f; ab[e2][r] = 0.f; }
#pragma unroll
        for (int s = 0; s < 8; ++s) {
            const int drow = 16 * s + 8 * hi + trow;
#pragma unroll
            for (int e2 = 0; e2 < 2; ++e2) {
                const int eb = 2 * eh + e2;
                const bf16x8 f1 = tr_frag(bufB + drow * 320 + (32 * eb + tcol) * 2, 4 * 320);
                af[e2] = mfma32(qf[s], f1, af[e2]);
                const bf16x8 f2 = tr_frag(bufC + drow * 320 + (32 * eb + tcol) * 2, 4 * 320);
                ab[e2] = mfma32(qf[s], f2, ab[e2]);
            }
        }
#pragma unroll
        for (int r = 0; r < 16; ++r) {
            const int irow = 32 * qb + crow(r, hi);
            const float sf = ex2(lgf2 * (float)(irow + 1)), sb = ex2(lgb2 * (float)(128 - irow));
#pragma unroll
            for (int e2 = 0; e2 < 2; ++e2) ot[e2][r] = af[e2][r] * sf + ab[e2][r] * sb;
        }
    }
    __syncthreads();
#pragma unroll
    for (int i = 0; i < 4; ++i) {
        const int cidx = tid + 512 * i, key = cidx >> 4, ch = cidx & 15;
        *(LAS u32x4*)(bufB + key * 320 + ch * 16) = *(const u32x4*)(V0 + (size_t)(r0 + key) * 512 + 128 * h + 8 * ch);
    }
    __syncthreads();
    {
        f32x16 p[4];
#pragma unroll
        for (int kb = 0; kb < 4; ++kb)
#pragma unroll
            for (int r = 0; r < 16; ++r) p[kb][r] = 0.f;
#pragma unroll
        for (int s = 0; s < 8; ++s)
#pragma unroll
            for (int kb = 0; kb < 4; ++kb) {
                const bf16x8 a = *(const LAS bf16x8*)(bufA + (32 * kb + r32) * 272 + (16 * s + 8 * hi) * 2);
                p[kb] = mfma32(a, qf[s], p[kb]);
            }
        const int iq = 32 * qb + r32;
        bf16x8 pa[8];
#pragma unroll
        for (int kb = 0; kb < 4; ++kb) {
#pragma unroll
            for (int r = 0; r < 16; ++r) {
                const int j = 32 * kb + crow(r, hi), dl = iq - j;
                const float wgt = dl >= 0 ? ex2(lgf2 * (float)dl) : ex2(lgb2 * (float)(-dl));
                p[kb][r] *= wgt;
            }
            pa[2 * kb] = pack8(p[kb][0], p[kb][1], p[kb][2], p[kb][3], p[kb][4], p[kb][5], p[kb][6], p[kb][7]);
            pa[2 * kb + 1] = pack8(p[kb][8], p[kb][9], p[kb][10], p[kb][11], p[kb][12], p[kb][13], p[kb][14], p[kb][15]);
        }
#pragma unroll
        for (int ks = 0; ks < 8; ++ks) {
            const int vrow = 16 * ks + 4 * hi + trow;
#pragma unroll
            for (int e2 = 0; e2 < 2; ++e2) {
                const int eb = 2 * eh + e2;
                const bf16x8 vf = tr_frag(bufB + vrow * 320 + (32 * eb + tcol) * 2, 8 * 320);
                ot[e2] = mfma32(pa[ks], vf, ot[e2]);
            }
        }
    }
#pragma unroll
    for (int r = 0; r < 16; ++r) {
        float ss = ot[0][r] * ot[0][r] + ot[1][r] * ot[1][r];
        ss = sum32(ss);
        if (r32 == 0) ssx[(qb * 32 + crow(r, hi)) * 2 + eh] = ss;
    }
    __syncthreads();
    ldsp st = lds + wid * 8704;
    const float rg0 = retg[128 * h + 64 * eh + r32], rg1 = retg[128 * h + 64 * eh + 32 + r32];
#pragma unroll
    for (int r = 0; r < 16; ++r) {
        const int lr = qb * 32 + crow(r, hi);
        const float rstd = __builtin_amdgcn_rsqf((ssx[lr * 2] + ssx[lr * 2 + 1]) * (1.f / 128.f) + EPS);
        LAS float* sp = (LAS float*)(st + crow(r, hi) * 272) + r32;
        sp[0] = ot[0][r] * rstd * rg0; sp[32] = ot[1][r] * rstd * rg1;
    }
    asm volatile("s_waitcnt lgkmcnt(0)" ::: "memory");
#pragma unroll
    for (int i = 0; i < 4; ++i) {
        const int idx = lane + 64 * i, row = idx >> 3, ch = idx & 7;
        const f32x4 a = *(const LAS f32x4*)(st + row * 272 + ch * 32), b = *(const LAS f32x4*)(st + row * 272 + ch * 32 + 16);
        const size_t grow = (size_t)(r0 + qb * 32 + row); const int col = 128 * h + 64 * eh + 8 * ch;
        const u32x4 g = *(const u32x4*)(SG + grow * 512 + col);
        u32x4 w; w.x = cvt_pk_bf16(a[0] * bflo(g.x), a[1] * bfhi(g.x)); w.y = cvt_pk_bf16(a[2] * bflo(g.y), a[3] * bfhi(g.y));
        w.z = cvt_pk_bf16(b[0] * bflo(g.z), b[1] * bfhi(g.z)); w.w = cvt_pk_bf16(b[2] * bflo(g.w), b[3] * bfhi(g.w));
        *(u32x4*)(QU + grow * 1024 + col) = w;
    }
    __syncthreads();
}

__device__ __forceinline__ float shx(float v, int lane, int o) { return __builtin_bit_cast(float, __builtin_amdgcn_ds_bpermute((lane ^ o) << 2, __builtin_bit_cast(int, v))); }
__device__ __forceinline__ void glds16(const void* gsrc, unsigned lds_dst) { unsigned keep;
    asm volatile("s_mov_b32 %0, m0\n\ts_mov_b32 m0, %2\n\ts_nop 0\n\tglobal_load_lds_dwordx4 %1, off\n\ts_mov_b32 m0, %0" : "=&s"(keep) : "v"(gsrc), "s"(lds_dst) : "memory"); }
__device__ __forceinline__ unsigned dma_off(int y, int P) { const int row = y / P, cw = y - P * row; return (unsigned)(row * 1024 + (cw < 16 ? cw : 15) * 8) * 2u; }
__device__ __forceinline__ void glds16s(const void* gbase, unsigned voff, unsigned lds_dst) { unsigned keep;
    asm volatile("s_mov_b32 %0, m0\n\ts_mov_b32 m0, %3\n\ts_nop 0\n\tglobal_load_lds_dwordx4 %1, %2\n\ts_mov_b32 m0, %0" : "=&s"(keep) : "v"(voff), "s"(gbase), "s"(lds_dst) : "memory"); }
#define ATTN_DMA(KOFS, VOFS, KT_BASE, VT_BASE) do { \
        const unsigned l0_ = (unsigned)(uintptr_t)lds + 1024u * (unsigned)wid; \
        glds16s(KT_BASE, dk0, l0_ + (KOFS)); glds16s(KT_BASE, dk1, l0_ + (KOFS) + 8192u); if (wid == 0) glds16s(KT_BASE, dk2, l0_ + (KOFS) + 16384u); \
        glds16s(VT_BASE, dv0, l0_ + (VOFS)); glds16s(VT_BASE, dv1, l0_ + (VOFS) + 8192u); if (wid < 4) glds16s(VT_BASE, dv2, l0_ + (VOFS) + 16384u); } while (0)
__device__ __forceinline__ void attn_phase(ldsp lds, const bf16_t* Q1, const bf16_t* K1, const bf16_t* V1, bf16_t* O,
                                           const float* lamp, const float* subg, int vcu) {
    const int wid = __builtin_amdgcn_readfirstlane(otid() >> 6);
    float lam_full;
    { const int lane = otid() & 63; const float la = wave_sum(lamp[lane] * lamp[64 + lane]), lb = wave_sum(lamp[128 + lane] * lamp[192 + lane]);
      lam_full = __builtin_bit_cast(float, __builtin_amdgcn_readfirstlane(__builtin_bit_cast(int, expf(la) - expf(lb) + LINIT1))); }
    for (int ui = 0; ui < 4; ++ui) {
        const int u = vcu + 256 * (ui & 1);
        int S, row0, head, qb;
        if (ui < 2) { S = 4096; row0 = (u >> 7) * 4096; head = (u >> 4) & 7; qb = u & 15; }
        else { S = 8192; row0 = NPROMPT + (u >> 8) * 8192; head = (u >> 5) & 7; qb = u & 31; }
        const int NT = S / 64;
        const int qrow0 = row0 + qb * 256 + wid * 32;
        ldsp Qw = lds + 77824 + wid * 8704;
        { const int lane = otid() & 63;
#pragma unroll
          for (int i = 0; i < 8; ++i) { const int idx = lane + 64 * i, row = idx >> 4, ch = idx & 15;
              *(LAS u32x4*)(Qw + row * 272 + ch * 16) = *(const u32x4*)(Q1 + (size_t)(qrow0 + row) * 1024 + 128 * head + 8 * ch); } }
        const bf16_t* kbase = K1 + (size_t)row0 * 1024 + 128 * head; const bf16_t* vbase = V1 + (size_t)row0 * 1024 + 128 * head;
        f32x16 o[2][4];
#pragma unroll
        for (int c = 0; c < 2; ++c)
#pragma unroll
            for (int eb = 0; eb < 4; ++eb)
#pragma unroll
                for (int r = 0; r < 16; ++r) o[c][eb][r] = 0.f;
        float l0 = 0.f, l1 = 0.f;
        unsigned dk0, dk1, dk2, dv0, dv1, dv2;
        { const int lane = otid() & 63; dk0 = dma_off(64 * wid + lane, 17); dk1 = dma_off(64 * (wid + 8) + lane, 17); dk2 = dma_off(64 * 16 + lane, 17);
          dv0 = dma_off(64 * wid + lane, 20); dv1 = dma_off(64 * (wid + 8) + lane, 20); dv2 = dma_off(64 * (wid + 16) + lane, 20); }
        ATTN_DMA(0u, 34816u, kbase, vbase);
        asm volatile("s_waitcnt vmcnt(0)" ::: "memory");
        __syncthreads();
        for (int kt = 0; kt < NT; ++kt) {
            const int cur = kt & 1;
            const bool more = (kt + 1 < NT);
            const int tid = otid(), lane = tid & 63, r32 = lane & 31, hi = lane >> 5;
            const int trow = (lane & 15) >> 2, tcol = 16 * ((lane >> 4) & 1) + 4 * (lane & 3);
            ldsp Kb = lds + cur * 17408 + r32 * 272 + 16 * hi, Vb = lds + 34816 + cur * 20480 + (4 * hi + trow) * 320 + tcol * 2;
            ldsp qrd = Qw + r32 * 272 + 16 * hi;
            if (more) ATTN_DMA((unsigned)(cur ^ 1) * 17408u, 34816u + (unsigned)(cur ^ 1) * 20480u, kbase + (size_t)(kt + 1) * 64 * 1024, vbase + (size_t)(kt + 1) * 64 * 1024);
#define SBAR_ __builtin_amdgcn_sched_barrier(0)
#define SQL(C, S) do { kf0[S] = *(const LAS bf16x8*)(Kb + (64 * (C) + 16 * (S)) * 2); kf1[S] = *(const LAS bf16x8*)(Kb + 32 * 272 + (64 * (C) + 16 * (S)) * 2); \
        qfv[S] = *(const LAS bf16x8*)(qrd + (64 * (C) + 16 * (S)) * 2); } while (0)
#define SQM(S, P0, P1) do { __builtin_amdgcn_s_setprio(1); P0 = mfma32(kf0[S], qfv[S], P0); P1 = mfma32(kf1[S], qfv[S], P1); __builtin_amdgcn_s_setprio(0); } while (0)
#define SQT(C, P0, P1, HOOK) do { _Pragma("unroll") for (int r = 0; r < 16; ++r) { P0[r] = 0.f; P1[r] = 0.f; } \
        SQL(C, 1); SBAR_; SQM(0, P0, P1); SQL(C, 2); SBAR_; SQM(1, P0, P1); SQL(C, 3); SBAR_; SQM(2, P0, P1); HOOK; SBAR_; SQM(3, P0, P1); SBAR_; } while (0)
#define VFL2(VF, KS, H) do { VF[2 * (H)] = tr_frag(Vb + 16 * (KS) * 320 + 64 * (2 * (H)), 8 * 320); VF[2 * (H) + 1] = tr_frag(Vb + 16 * (KS) * 320 + 64 * (2 * (H) + 1), 8 * 320); } while (0)
#define VFL(VF, KS) do { VFL2(VF, KS, 0); VFL2(VF, KS, 1); } while (0)
#define VWORK(P, B, G, W, RS) do { const float e0_ = ex2(P[(B) + 2 * (G)]), e1_ = ex2(P[(B) + 2 * (G) + 1]); RS += e0_ + e1_; W[G] = cvt_pk_bf16(e0_, e1_); } while (0)
#define GRP(OC, WCUR, VFCUR, VFNEXT, KSNEXT, P, B, WNEXT, RS, PRE) do { __builtin_amdgcn_s_setprio(1); \
        OC[0] = mfma32(__builtin_bit_cast(bf16x8, WCUR), VFCUR[0], OC[0]); if (PRE) VFL2(VFNEXT, KSNEXT, 0); VWORK(P, B, 0, WNEXT, RS); SBAR_; \
        OC[1] = mfma32(__builtin_bit_cast(bf16x8, WCUR), VFCUR[1], OC[1]); VWORK(P, B, 1, WNEXT, RS); SBAR_; \
        OC[2] = mfma32(__builtin_bit_cast(bf16x8, WCUR), VFCUR[2], OC[2]); if (PRE) VFL2(VFNEXT, KSNEXT, 1); VWORK(P, B, 2, WNEXT, RS); SBAR_; \
        OC[3] = mfma32(__builtin_bit_cast(bf16x8, WCUR), VFCUR[3], OC[3]); VWORK(P, B, 3, WNEXT, RS); __builtin_amdgcn_s_setprio(0); SBAR_; } while (0)
            {
                f32x16 pA0, pA1, pB0, pB1; u32x4 wA, wB; bf16x8 vfA[4], vfB[4], kf0[4], kf1[4], qfv[4];
                SQL(0, 0); SBAR_;
                SQT(0, pA0, pA1, (void)0);
                VFL(vfA, 0);
                VWORK(pA0, 0, 0, wA, l0); VWORK(pA0, 0, 1, wA, l0); VWORK(pA0, 0, 2, wA, l0); VWORK(pA0, 0, 3, wA, l0); SBAR_;
                GRP(o[0], wA, vfA, vfB, 1, pA0, 8, wB, l0, true);
                GRP(o[0], wB, vfB, vfA, 2, pA1, 0, wA, l0, true);
                GRP(o[0], wA, vfA, vfB, 3, pA1, 8, wB, l0, false);
                SQL(1, 0); SBAR_;
                SQT(1, pB0, pB1, VFL(vfB, 3));
                GRP(o[0], wB, vfB, vfA, 0, pB0, 0, wA, l1, true);
                GRP(o[1], wA, vfA, vfB, 1, pB0, 8, wB, l1, true);
                GRP(o[1], wB, vfB, vfA, 2, pB1, 0, wA, l1, true);
                GRP(o[1], wA, vfA, vfB, 3, pB1, 8, wB, l1, true);
#pragma unroll
                for (int eb = 0; eb < 4; ++eb) o[1][eb] = mfma32(__builtin_bit_cast(bf16x8, wB), vfB[eb], o[1][eb]);
                SBAR_;
            }
#undef SQT
#undef SQL
#undef SQM
#undef VFL
#undef VWORK
#undef GRP
#undef SBAR_
            asm volatile("s_waitcnt vmcnt(0)" ::: "memory");
            __syncthreads();
        }
        {
            const int lane = otid() & 63, r32 = lane & 31, hi = lane >> 5;
            LAS float* lsc = (LAS float*)(lds + 75776) + wid * 64;
            l0 += shx(l0, lane, 32); l1 += shx(l1, lane, 32);
            if (hi == 0) { lsc[r32] = l0; lsc[32 + r32] = l1; }
            asm volatile("s_waitcnt lgkmcnt(0)" ::: "memory");
            const float g0 = subg[r32], g1 = subg[32 + r32], g2 = subg[64 + r32], g3 = subg[96 + r32];
#pragma unroll
            for (int r = 0; r < 16; ++r) {
                const int lr = crow(r, hi);
                const float i0 = __builtin_amdgcn_rcpf(lsc[lr]), i1 = lam_full * __builtin_amdgcn_rcpf(lsc[32 + lr]);
                const float v0 = o[0][0][r] * i0 - o[1][0][r] * i1, v1 = o[0][1][r] * i0 - o[1][1][r] * i1;
                const float v2 = o[0][2][r] * i0 - o[1][2][r] * i1, v3 = o[0][3][r] * i0 - o[1][3][r] * i1;
                float ss = (v0 * v0 + v1 * v1) + (v2 * v2 + v3 * v3);
                ss += shx(ss, lane, 1); ss += shx(ss, lane, 2); ss += shx(ss, lane, 4); ss += shx(ss, lane, 8); ss += shx(ss, lane, 16);
                const float rstd = __builtin_amdgcn_rsqf(ss * (1.f / 128.f) + EPS) * (1.f - LINIT1);
                LAS unsigned short* sp = (LAS unsigned short*)(Qw + lr * 272) + r32;
                sp[0] = f2bf(v0 * rstd * g0); sp[32] = f2bf(v1 * rstd * g1); sp[64] = f2bf(v2 * rstd * g2); sp[96] = f2bf(v3 * rstd * g3);
            }
            asm volatile("s_waitcnt lgkmcnt(0)" ::: "memory");
#pragma unroll
            for (int i = 0; i < 8; ++i) { const int idx = lane + 64 * i, row = idx >> 4, ch = idx & 15;
                *(u32x4*)(O + (size_t)(qrow0 + row) * 1024 + 128 * head + 8 * ch) = *(const LAS u32x4*)(Qw + row * 272 + ch * 16); }
            asm volatile("s_waitcnt lgkmcnt(0)" ::: "memory");
        }
    }
}

struct Args { const float* in[18]; float* out; unsigned char* ws; int ph_lo, ph_hi; };
constexpr int N_PHASES = 17;

template <class Epi>
__device__ __forceinline__ void run_gemm(ldsp lds, const bf16_t* A, const bf16_t* Bt, int N, int K, const Epi& E) {
    pg8::Gemm g{A, Bt, M, N, K}; pg8::StaticOrder S; S.init(M, N, 256, obx());
#ifndef NO_GEMM
    pg8::gemm_phase<Epi, pg8::StaticOrder, true, true>(lds, g, S, E);
#endif
}
#define WSP(off) ((bf16_t*)(a.ws + (off)))
#define SSP(k) ((unsigned long long*)(a.ws + WS_SS) + (size_t)(k) * M)
__device__ __forceinline__ void ph_prologue(const Args& a, ldsp lds) {
    const int tid = otid(), lane = tid & 63, wid = __builtin_amdgcn_readfirstlane(tid >> 6), bx = obx(), gw = bx * 8 + wid;
    LAS float* scr = (LAS float*)(lds + wid * 16384);
    constexpr int I_FFI = 16 * 176, I_FFO = 44 * 32, I_IN = 16 * 96, I_OUT = 16 * 32;
    constexpr int NITEMS = 4 * I_FFI + 4 * I_FFO + 2 * I_IN + 2 * I_OUT;
    const float* ng = a.in[2];
    for (int it = gw; it < NITEMS; it += 2048) {
        int r = it;
        if (r < 4 * I_FFI) { const int mi = r / I_FFI; const int gi = (mi >> 1) * 3 + ((mi & 1) ? 2 : 0);
            transpose_item(a.in[3] + (size_t)mi * 1024 * 5632, 1024, 5632, 1, WSP(WS_FFI + mi * W_FFI), scr, r % I_FFI, lane, ng + gi * D); continue; } r -= 4 * I_FFI;
        if (r < 4 * I_FFO) { const int mi = r / I_FFO; transpose_item(a.in[4] + (size_t)mi * 2816 * 1024, 2816, 1024, 0, WSP(WS_FFO + mi * W_FFO), scr, r % I_FFO, lane, nullptr); continue; } r -= 4 * I_FFO;
        if (r < I_IN) { transpose_item(a.in[5], 1024, 3072, 2, WSP(WS_ABI), scr, r, lane, ng + 1 * D); continue; } r -= I_IN;
        if (r < I_IN) { transpose_item(a.in[12], 1024, 3072, 3, WSP(WS_CI), scr, r, lane, ng + 4 * D); continue; } r -= I_IN;
        if (r < I_OUT) { transpose_item(a.in[11], 1024, 1024, 0, WSP(WS_ABO), scr, r, lane, nullptr); continue; } r -= I_OUT;
        transpose_item(a.in[17], 1024, 1024, 0, WSP(WS_CO), scr, r, lane, nullptr);
    }
    float* tab0 = (float*)(a.ws + WS_TAB0); float* tab1 = (float*)(a.ws + WS_TAB1);
    for (int e = bx * 512 + tid; e < 8192 * 96; e += 256 * 512) { if (e < 8192 * 64) rope_entry(tab0, 64, e); else rope_entry(tab1, 32, e - 8192 * 64); }
    for (int e = bx * 512 + tid; e < 5 * M; e += 256 * 512) SSP(1)[e] = 0ull;
    norm_phase(a.in[0], a.in[1], SSP(0), WSP(WS_XN), gw, lane);
}
__device__ __forceinline__ void ph_ffn_in(const Args& a, ldsp lds, int wi, int k) { run_gemm(lds, WSP(WS_XN), WSP(WS_FFI + (size_t)wi * W_FFI), 5632, 1024, EpiSwiglu{WSP(WS_H), SSP(k)}); }
template <int MODE>
__device__ __forceinline__ void ph_ffn_out(const Args& a, ldsp lds, int wi, int k) {
    run_gemm(lds, WSP(WS_H), WSP(WS_FFO + (size_t)wi * W_FFO), 1024, 2816, EpiResid<MODE>{a.in[0], a.in[1], a.out, 0.5f, WSP(WS_XN), SSP(k)});
}
__device__ __forceinline__ void ph_outproj(const Args& a, ldsp lds, size_t aoff, size_t woff, int k) {
    run_gemm(lds, WSP(aoff), WSP(woff), 1024, 1024, EpiResid<1>{a.in[0], a.in[1], a.out, 1.0f, WSP(WS_XN), SSP(k)});
}

__global__ void __launch_bounds__(512, 2) fwd_kernel(Args a_in) {
    extern __shared__ __attribute__((aligned(16))) unsigned char lds_raw[];
    cg::grid_group grid = cg::this_grid();
    ldsp lds = (ldsp)lds_raw;
    const Args& a0 = a_in;
    if (threadIdx.x < 16) ((LAS unsigned*)(lds + LDS_MISC))[threadIdx.x] = 0u;
    __syncthreads();
    XcdBarrier bar = xcd_barrier_post((unsigned*)(a_in.ws + WS_CTL), (volatile LAS unsigned*)(lds + LDS_MISC));
    for (int ph = a0.ph_lo; ph < a0.ph_hi; ++ph) {
        Args a = a0; asm volatile("" : "+s"(a.ws), "+s"(a.out));
        switch (ph) {
        case 0: ph_prologue(a, lds); break;
        case 1: ph_ffn_in(a, lds, 0, 0); break;
        case 2: ph_ffn_out<0>(a, lds, 0, 1); break;
        case 3:
            run_gemm(lds, WSP(WS_XN), WSP(WS_ABI), 3072, 1024, EpiABAll{WSP(WS_QU), WSP(WS_K0), WSP(WS_V0), WSP(WS_SG), WSP(WS_U), (const float*)(a.ws + WS_TAB0), SSP(1)});
            break;
        case 4: {
            const int bx = obx(); const float lgf2 = -expf(a.in[6][(bx & 3)]) * LOG2E, lgb2 = -expf(a.in[6][4 + (bx & 3)]) * LOG2E;
            for (int i = 0; i < 4; ++i) r1_unit(lds, bx + 256 * i, WSP(WS_K0), WSP(WS_V0), (bf16_t*)a.out, lgf2, lgb2);
            for (int i = 0; i < 4; ++i) conv_tile(lds, bx + 256 * i, WSP(WS_U), a.in[8], a.in[9], a.in[10], WSP(WS_QU));
        } break;
        case 5: scan_phase((bf16_t*)a.out, a.in[6], obx() * 512 + otid()); break;
        case 6: {
            const int bx = obx(); const float lgf2 = -expf(a.in[6][(bx & 3)]) * LOG2E, lgb2 = -expf(a.in[6][4 + (bx & 3)]) * LOG2E;
            for (int i = 0; i < 4; ++i) r3_unit(lds, bx + 256 * i, WSP(WS_QU), WSP(WS_K0), WSP(WS_V0), WSP(WS_SG), (bf16_t*)a.out, a.in[7], lgf2, lgb2);
        } break;
        case 7: ph_outproj(a, lds, WS_QU, WS_ABO, 2); break;
        case 8: ph_ffn_in(a, lds, 1, 2); break;
        case 9: ph_ffn_out<1>(a, lds, 1, 3); break;
        case 10: ph_ffn_in(a, lds, 2, 3); break;
        case 11: ph_ffn_out<1>(a, lds, 2, 4); break;
        case 12: run_gemm(lds, WSP(WS_XN), WSP(WS_CI), 3072, 1024, EpiC{WSP(WS_Q1), WSP(WS_K1), WSP(WS_V1), (const float*)(a.ws + WS_TAB1), a.in[13], a.in[14], SSP(4)}); break;
        case 13: {
            const int bx = obx(); const int vcu = (bx % 8) * 32 + bx / 8;
            attn_phase(lds, WSP(WS_Q1), WSP(WS_K1), WSP(WS_V1), WSP(WS_Q1), a.in[15], a.in[16], vcu);
        } break;
        case 14: ph_outproj(a, lds, WS_Q1, WS_CO, 5); break;
        case 15: ph_ffn_in(a, lds, 3, 5); break;
        case 16: ph_ffn_out<2>(a, lds, 3, 0); break;
        default: break;
        }
        if (ph + 1 < a0.ph_hi) { if (a0.ph_hi > 1000) grid.sync(); else xcd_barrier(bar); }
    }
}
}

extern "C" void kernel_launch(void* const* d_in, const int* in_sizes, int n_in, void* d_out, int out_size, void* d_ws, size_t ws_size, hipStream_t stream) {
    static int grid = 0;
    if (grid == 0) {
        if (n_in != 18 || out_size != mk::M * mk::D || ws_size < mk::WS_END) { fprintf(stderr, "kernel_launch: unexpected shapes n_in %d out %d ws %zu\n", n_in, out_size, ws_size); grid = -1; return; }
        int dev = 0, cus = 0, per_cu = 0;
        (void)hipGetDevice(&dev); (void)hipDeviceGetAttribute(&cus, hipDeviceAttributeMultiprocessorCount, dev);
        (void)hipFuncSetAttribute((const void*)mk::fwd_kernel, hipFuncAttributeMaxDynamicSharedMemorySize, mk::LDS_BYTES);
        (void)hipOccupancyMaxActiveBlocksPerMultiprocessor(&per_cu, (const void*)mk::fwd_kernel, 512, mk::LDS_BYTES);
        (void)hipGetLastError();
        grid = cus > 0 ? cus : 256;
        if (grid > 256) grid = 256;
    }
    if (grid < 0) return;
    mk::Args a{};
    for (int i = 0; i < 18; ++i) a.in[i] = (const float*)d_in[i];
    a.out = (float*)d_out; a.ws = (unsigned char*)d_ws; a.ph_lo = 0; a.ph_hi = mk::N_PHASES;
    (void)hipMemsetAsync((char*)d_ws + mk::WS_CTL, 0, mk::CTL_BYTES, stream);
    void* args[] = {&a};
    hipError_t e = hipLaunchCooperativeKernel((const void*)mk::fwd_kernel, dim3(grid), dim3(512), args, mk::LDS_BYTES, stream);
    if (e != hipSuccess) fprintf(stderr, "cooperative launch failed: %s (grid %d)\n", hipGetErrorString(e), grid);
}
```

```cpp
#include <hip/hip_runtime.h>
#include <hip/hip_cooperative_groups.h>
#include <cstdio>
#include <cstdint>
namespace cg = cooperative_groups;
namespace pg8 {
#define PG8_LAS __attribute__((address_space(3)))
typedef unsigned short bf16_t;
typedef short bf16x8 __attribute__((ext_vector_type(8)));
typedef float f32x4 __attribute__((ext_vector_type(4)));
typedef unsigned u32x4 __attribute__((ext_vector_type(4)));
constexpr int BM = 256, BK = 64, HALF = 128, HTB = HALF * BK * 2  , STAGE_BYTES = 8 * HTB, NXCD = 8, WGM = 8;

__host__ __device__ __forceinline__ int lds_byte(int r, int c) { const int st = (r >> 4) * 2 + (c >> 5), rr = r & 15, cc = c & 31, ob = rr * 64 + cc * 2; return st * 1024 + (ob ^ (((ob >> 9) & 1) << 5)); }
__host__ __device__ __forceinline__ void stage_rc(int b, int& R, int& C) { const int st = b / 1024, sb = b % 1024, swz = sb ^ (((sb >> 9) & 1) << 5); R = (st >> 1) * 16 + swz / 64; C = (st & 1) * 32 + (swz % 64) / 2; }
__host__ __device__ __forceinline__ int perm32(int rho) { const int n = rho >> 4, i = rho & 15; return 8 * (i >> 2) + 4 * n + (i & 3); }

struct Unit { int pm, pn; };
struct Gemm { const bf16_t* A; const bf16_t* Bt; int M, N, K; };

struct StaticOrder {
    int nM, nN, nwg, G, c;
    __host__ __device__ void init(int M, int N, int G_, int c_) { nM = M / BM; nN = N / BM; nwg = nM * nN; G = G_; c = c_; }
    __host__ __device__ bool next(int i, Unit& u) const {
        const long L = (long)i * G + c; if (L >= nwg) return false;
        int wgid = (int)L; { const int q = nwg / NXCD, r = nwg % NXCD, xcd = wgid % NXCD, off = wgid / NXCD; wgid = (xcd < r ? xcd * (q + 1) : r * (q + 1) + (xcd - r) * q) + off; }
        const int nig = WGM * nN, gid = wgid / nig, fm = gid * WGM, gsz = (nM - fm) < WGM ? (nM - fm) : WGM;
        u.pm = fm + ((wgid % nig) % gsz); u.pn = (wgid % nig) / gsz; return true;
    }
    __device__ __forceinline__ void a_ready(const Unit&) const {}
    __device__ __forceinline__ void done(const Unit&) const {}
};

typedef float f32x2cv __attribute__((ext_vector_type(2))); typedef __bf16 bf16x2cv __attribute__((ext_vector_type(2)));
__device__ __forceinline__ unsigned cvt_pk_bf16(float lo, float hi) { f32x2cv v = {lo, hi}; bf16x2cv b = __builtin_convertvector(v, bf16x2cv); return __builtin_bit_cast(unsigned, b); }
typedef float f32x2 __attribute__((ext_vector_type(2)));
template <class Epi, class Sched, bool ALIGN_EPI = false, bool SP2 = false>
__device__ __forceinline__ void gemm_phase(PG8_LAS unsigned char* lds, const Gemm g, const Sched& S, const Epi& E) {
    int tid_ = threadIdx.x; asm volatile("" : "+v"(tid_)); const int tid = tid_, wid = __builtin_amdgcn_readfirstlane(tid >> 6), lane = tid & 63, wr = wid >> 2, wc = wid & 3, fr = lane & 15, fq = lane >> 4;
    const int K = g.K, nt = K / BK;
    unsigned voffA[2], voffB[2];
#pragma unroll
    for (int i = 0; i < 2; ++i) { int R, C; stage_rc(tid * 16 + i * 8192, R, C); const int Rb = Epi::PERM ? ((R & ~31) + perm32(R & 31)) : R;
        voffA[i] = (unsigned)(R * K + C) * 2u; voffB[i] = (unsigned)(Rb * K + C) * 2u; }
    const size_t kstep = (size_t)(BK * 2);
    const size_t hstep = (size_t)HALF * K * 2;
    const size_t tstep = 2 * hstep;
    const unsigned ldsw = (unsigned)wid * 1024u;
    const int aoff = lds_byte(wr * 64 + fr, fq * 8), boff = lds_byte(wc * 32 + fr, fq * 8);
#define PG8_SA(b, h) (((b) * 2 + (h)) * HTB)
#define PG8_SB(b, h) ((4 + (b) * 2 + (h)) * HTB)
#define PG8_STAGE(bufoff, gbase, voff) do { _Pragma("unroll") for (int _i = 0; _i < 2; ++_i) \
        __builtin_amdgcn_global_load_lds((const unsigned*)((const char*)(gbase) + (voff)[_i]), (PG8_LAS unsigned*)(lds + (bufoff) + ldsw + _i * 8192), 16, 0, 0); } while (0)
#define PG8_LDA(dst, b, h) do { _Pragma("unroll") for (int m = 0; m < 4; ++m) _Pragma("unroll") for (int k = 0; k < 2; ++k) dst[m][k] = *(const PG8_LAS bf16x8*)(lds + PG8_SA(b, h) + aoff + m * 2048 + k * 1024); } while (0)
#define PG8_LDB(dst, b, h) do { _Pragma("unroll") for (int n = 0; n < 2; ++n) _Pragma("unroll") for (int k = 0; k < 2; ++k) dst[n][k] = *(const PG8_LAS bf16x8*)(lds + PG8_SB(b, h) + boff + n * 2048 + k * 1024); } while (0)
#define PG8_MMA(ai, bj, At, Bt) do { __builtin_amdgcn_s_setprio(1); _Pragma("unroll") for (int m = 0; m < 4; ++m) _Pragma("unroll") for (int n = 0; n < 2; ++n) _Pragma("unroll") for (int k = 0; k < 2; ++k) \
        acc[ai][bj][m][n] = __builtin_amdgcn_mfma_f32_16x16x32_bf16(Bt[n][k], At[m][k], acc[ai][bj][m][n], 0, 0, 0); __builtin_amdgcn_s_setprio(0); } while (0)
#define PG8_WAIT_V(n) asm volatile("s_waitcnt vmcnt(" #n ")" ::: "memory")
#define PG8_WAIT_L(n) asm volatile("s_waitcnt lgkmcnt(" #n ")" ::: "memory")
#define PG8_BAR __builtin_amdgcn_s_barrier()
#define PG8_SCHED __builtin_amdgcn_sched_barrier(0)
    Unit cur, nxt; int ui = 0;
    if (!S.next(0, cur)) return;
    f32x4 acc[2][2][4][2];
#pragma unroll
    for (int a = 0; a < 2; ++a)
#pragma unroll
        for (int b = 0; b < 2; ++b)
#pragma unroll
            for (int m = 0; m < 4; ++m)
#pragma unroll
                for (int n = 0; n < 2; ++n) acc[a][b][m][n] = (f32x4){0.f, 0.f, 0.f, 0.f};
    bf16x8 At[4][2], B0[2][2], B1[2][2];
    const char* cA = (const char*)g.A + (size_t)cur.pm * tstep; const char* cB = (const char*)g.Bt + (size_t)cur.pn * tstep;
    S.a_ready(cur);
    if constexpr (SP2) {
        PG8_STAGE(PG8_SB(0, 0), cB, voffB); PG8_STAGE(PG8_SB(0, 1), cB + hstep, voffB); PG8_STAGE(PG8_SA(0, 0), cA, voffA); PG8_STAGE(PG8_SA(0, 1), cA + hstep, voffA);
        if (wr == 1) PG8_BAR;
        PG8_WAIT_V(2); PG8_BAR;
        PG8_STAGE(PG8_SB(1, 0), cB + kstep, voffB); PG8_STAGE(PG8_SA(1, 0), cA + kstep, voffA); PG8_STAGE(PG8_SB(1, 1), cB + hstep + kstep, voffB);
        PG8_WAIT_V(6); PG8_BAR;
    } else {
        PG8_STAGE(PG8_SB(0, 0), cB, voffB); PG8_STAGE(PG8_SA(0, 0), cA, voffA); PG8_STAGE(PG8_SB(0, 1), cB + hstep, voffB); PG8_STAGE(PG8_SA(0, 1), cA + hstep, voffA);
        if (wr == 1) PG8_BAR;
        PG8_WAIT_V(4); PG8_BAR;
        PG8_STAGE(PG8_SB(1, 0), cB + kstep, voffB); PG8_STAGE(PG8_SA(1, 0), cA + kstep, voffA); PG8_STAGE(PG8_SB(1, 1), cB + hstep + kstep, voffB);
        PG8_WAIT_V(6); PG8_BAR;
    }
    for (;;) {
        const bool has_next = S.next(ui + 1, nxt);
        const char* nA = has_next ? (const char*)g.A + (size_t)nxt.pm * tstep : cA; const char* nB = has_next ? (const char*)g.Bt + (size_t)nxt.pn * tstep : cB;
        for (int t = 0; t < nt; t += 2) {
            const bool last = (t == nt - 2);
            const char* a1 = cA + (size_t)(t + 1) * kstep;
            const char* a2 = last ? nA : cA + (size_t)(t + 2) * kstep; const char* b2 = last ? nB : cB + (size_t)(t + 2) * kstep;
            const char* a3 = a2 + kstep; const char* b3 = b2 + kstep;
            if (last && has_next) S.a_ready(nxt);
            if constexpr (SP2) {
            PG8_LDB(B0, 0, 0); PG8_LDB(B1, 0, 1); PG8_SCHED; PG8_LDA(At, 0, 0); PG8_STAGE(PG8_SA(1, 1), a1 + hstep, voffA);
            PG8_WAIT_V(8); PG8_WAIT_L(0); PG8_BAR; PG8_MMA(0, 0, At, B0); PG8_MMA(0, 1, At, B1); PG8_BAR; PG8_SCHED;
            PG8_LDA(At, 0, 1); PG8_STAGE(PG8_SB(0, 0), b2, voffB); PG8_STAGE(PG8_SB(0, 1), b2 + hstep, voffB); PG8_STAGE(PG8_SA(0, 0), a2, voffA);
            PG8_WAIT_V(8); PG8_WAIT_L(0); PG8_BAR; PG8_MMA(1, 0, At, B0); PG8_MMA(1, 1, At, B1); PG8_BAR; PG8_SCHED;
            PG8_LDB(B0, 1, 0); PG8_LDB(B1, 1, 1); PG8_SCHED; PG8_LDA(At, 1, 0); PG8_STAGE(PG8_SA(0, 1), a2 + hstep, voffA);
            PG8_WAIT_V(8); PG8_WAIT_L(0); PG8_BAR; PG8_MMA(0, 0, At, B0); PG8_MMA(0, 1, At, B1); PG8_BAR; PG8_SCHED;
            PG8_LDA(At, 1, 1); PG8_STAGE(PG8_SB(1, 0), b3, voffB); PG8_STAGE(PG8_SB(1, 1), b3 + hstep, voffB); PG8_STAGE(PG8_SA(1, 0), a3, voffA);
            PG8_WAIT_V(8); PG8_WAIT_L(0); PG8_BAR; PG8_MMA(1, 0, At, B0); PG8_MMA(1, 1, At, B1); PG8_BAR; PG8_SCHED;
            } else {
            PG8_LDB(B0, 0, 0); PG8_SCHED; PG8_LDA(At, 0, 0); PG8_STAGE(PG8_SA(1, 1), a1 + hstep, voffA);
            PG8_WAIT_L(8); PG8_BAR; PG8_WAIT_L(0); PG8_MMA(0, 0, At, B0); PG8_BAR; PG8_SCHED;
            PG8_LDB(B1, 0, 1); PG8_STAGE(PG8_SB(0, 0), b2, voffB);
            PG8_BAR; PG8_WAIT_L(0); PG8_MMA(0, 1, At, B1); PG8_BAR;
            PG8_LDA(At, 0, 1); PG8_STAGE(PG8_SA(0, 0), a2, voffA);
            PG8_BAR; PG8_WAIT_L(0); PG8_MMA(1, 0, At, B0); PG8_BAR; PG8_SCHED;
            PG8_STAGE(PG8_SB(0, 1), b2 + hstep, voffB);
            PG8_WAIT_V(6); PG8_BAR; PG8_MMA(1, 1, At, B1); PG8_BAR;
            PG8_LDB(B0, 1, 0); PG8_SCHED; PG8_LDA(At, 1, 0); PG8_STAGE(PG8_SA(0, 1), a2 + hstep, voffA);
            PG8_WAIT_L(8); PG8_BAR; PG8_WAIT_L(0); PG8_MMA(0, 0, At, B0); PG8_BAR; PG8_SCHED;
            PG8_LDB(B1, 1, 1); PG8_STAGE(PG8_SB(1, 0), b3, voffB);
            PG8_BAR; PG8_WAIT_L(0); PG8_MMA(0, 1, At, B1); PG8_BAR;
            PG8_LDA(At, 1, 1); PG8_STAGE(PG8_SA(1, 0), a3, voffA);
            PG8_BAR; PG8_WAIT_L(0); PG8_MMA(1, 0, At, B0); PG8_BAR; PG8_SCHED;
            PG8_STAGE(PG8_SB(1, 1), b3 + hstep, voffB);
            PG8_WAIT_V(6); PG8_BAR; PG8_MMA(1, 1, At, B1); PG8_BAR;
            }
        }
        if constexpr (ALIGN_EPI) { if (wr == 0) PG8_BAR; }
        if constexpr (!Epi::AFTER_DRAIN) { E(acc, cur, wr, wc, fr, fq); S.done(cur); }
        if (!has_next) break;
#pragma unroll
        for (int a = 0; a < 2; ++a)
#pragma unroll
            for (int b = 0; b < 2; ++b)
#pragma unroll
                for (int m = 0; m < 4; ++m)
#pragma unroll
                    for (int n = 0; n < 2; ++n) acc[a][b][m][n] = (f32x4){0.f, 0.f, 0.f, 0.f};
        cur = nxt; cA = nA; cB = nB; ++ui;
        if constexpr (ALIGN_EPI) { if (wr == 1) PG8_BAR; }
    }
    PG8_WAIT_V(0);
    if constexpr (!ALIGN_EPI) { if (wr == 0) PG8_BAR; }
    PG8_BAR;
    if constexpr (Epi::AFTER_DRAIN) { E.fused(acc, cur, wr, wc, fr, fq, lds, wid, lane); S.done(cur); }
#undef PG8_SA
#undef PG8_SB
#undef PG8_STAGE
#undef PG8_LDA
#undef PG8_LDB
#undef PG8_MMA
#undef PG8_WAIT_V
#undef PG8_WAIT_L
#undef PG8_BAR
#undef PG8_SCHED
}
}

namespace mk {
using pg8::bf16_t; using pg8::bf16x8; using pg8::f32x4; using pg8::u32x4; using pg8::Unit; using pg8::cvt_pk_bf16;
#define LAS __attribute__((address_space(3)))
typedef LAS unsigned char* ldsp;
typedef float f32x16 __attribute__((ext_vector_type(16)));
typedef short v4i16 __attribute__((ext_vector_type(4)));

constexpr int M = 32768, D = 1024, DFF = 2816, NPROMPT = 16384;
constexpr float EPS = 1e-6f, LOG2E = 1.4426950408889634f;
constexpr float LINIT1 = 0.35550906759096924f;
constexpr int LDS_BYTES = 147456 + 64, LDS_MISC = 147456;

constexpr size_t MiB = 1u << 20;
constexpr size_t WS_TAB0 = 0, WS_TAB1 = 4 * MiB;
constexpr size_t WS_SS = 6 * MiB;
constexpr size_t WS_CTL = 7 * MiB + 768 * 1024, CTL_BYTES = 16384;
constexpr size_t WS_W = 8 * MiB;
constexpr size_t W_FFI = (size_t)5632 * 1024 * 2, W_FFO = (size_t)1024 * 2816 * 2, W_IN = (size_t)3072 * 1024 * 2, W_OUT = (size_t)1024 * 1024 * 2;
constexpr size_t WS_FFI = WS_W, WS_FFO = WS_FFI + 4 * W_FFI, WS_ABI = WS_FFO + 4 * W_FFO, WS_CI = WS_ABI + W_IN, WS_ABO = WS_CI + W_IN, WS_CO = WS_ABO + W_OUT;
constexpr size_t WS_XN = 90 * MiB;
constexpr size_t WS_BIG = 154 * MiB;
constexpr size_t WS_H = WS_BIG;
constexpr size_t WS_QU = WS_BIG, WS_K0 = WS_BIG + 64 * MiB, WS_V0 = WS_BIG + 96 * MiB, WS_SG = WS_BIG + 128 * MiB, WS_U = WS_BIG + 160 * MiB;
constexpr size_t WS_Q1 = WS_BIG, WS_K1 = WS_BIG + 64 * MiB, WS_V1 = WS_BIG + 128 * MiB;
constexpr size_t WS_END = 346 * MiB;
static_assert(WS_CO + W_OUT <= WS_XN, "weights fit");
static_assert(WS_H + (size_t)M * DFF * 2 <= WS_END, "h fits");

#define XB_TMO      128
#define XB_XCNT(j)  (256  + 64 * (j))
#define XB_XSUB(j)  (1280 + 64 * (j))
#define XB_XGEN(j)  (2304 + 64 * (j))
#define XB_TOP      3328
#define XB_TOPGEN   3392
#define XCD_BAR_WORDS 3456
#define XB_SPIN_CAP (1u << 18)

__device__ __forceinline__ unsigned xb_ld(unsigned* p)              { return __hip_atomic_load(p, __ATOMIC_RELAXED, __HIP_MEMORY_SCOPE_AGENT); }
__device__ __forceinline__ unsigned xb_add(unsigned* p, unsigned v) { return __hip_atomic_fetch_add(p, v, __ATOMIC_RELAXED, __HIP_MEMORY_SCOPE_AGENT); }
__device__ __forceinline__ unsigned xb_xcc_id() { return (unsigned)__builtin_amdgcn_s_getreg((3 << 11) | 20) & 0xFu; }
#define XB_SPIN(cond, bar) do { unsigned _sp = 0; while (cond) { __builtin_amdgcn_s_sleep(1); \
    if ((++_sp & 255u) == 0u) { if (xb_ld(&(bar)[XB_TMO])) break; if (_sp > XB_SPIN_CAP) { atomicAdd(&(bar)[XB_TMO], 1u); break; } } } } while (0)

struct XcdBarrier {
    unsigned* bar; unsigned x;
    volatile LAS unsigned* st;
};

__device__ __forceinline__ XcdBarrier xcd_barrier_post(unsigned* bar, volatile LAS unsigned* st) {
    XcdBarrier b; b.bar = bar; b.x = xb_xcc_id(); b.st = st;
    if (threadIdx.x == 0) (void)xb_add(&bar[XB_XCNT(b.x)], 1u);
    return b;
}
__device__ __forceinline__ void xcd_barrier_complete(unsigned* bar, unsigned x, unsigned& nloc, unsigned& nx) {
    const unsigned G = gridDim.x * gridDim.y * gridDim.z;
    unsigned sum, cnt, mine, sp = 0u;
    for (;;) {
        sum = 0u; cnt = 0u; mine = 0u;
#pragma unroll
        for (unsigned j = 0; j < 16; ++j) { const unsigned c = xb_ld(&bar[XB_XCNT(j)]); sum += c; cnt += (c > 0u) ? 1u : 0u; mine = (j == x) ? c : mine; }
        if (sum == G) break;
        __builtin_amdgcn_s_sleep(1);
        if ((++sp & 255u) == 0u) { if (xb_ld(&bar[XB_TMO])) break; if (sp > XB_SPIN_CAP) { atomicAdd(&bar[XB_TMO], 1u); break; } }
    }
    nloc = mine > 0u ? mine : 1u; nx = cnt > 0u ? cnt : 1u;
}

__device__ __forceinline__ void xcd_barrier(const XcdBarrier& b) {
    asm volatile("s_waitcnt vmcnt(0)" ::: "memory");
    __syncthreads();
    if (threadIdx.x == 0) {
        unsigned* bar = b.bar;
        __builtin_amdgcn_s_waitcnt(0);
        unsigned nloc = b.st[0], nx = b.st[1];
        if (nloc == 0u) { xcd_barrier_complete(bar, b.x, nloc, nx); b.st[0] = nloc; b.st[1] = nx; }
        const unsigned old = xb_add(&bar[XB_XSUB(b.x)], 1u);
        const unsigned gen = old / nloc;
        if (old + 1u == (gen + 1u) * nloc) {
            __builtin_amdgcn_fence(__ATOMIC_RELEASE, "agent");
            asm volatile("s_waitcnt vmcnt(0)" ::: "memory");
            const unsigned og = xb_add(&bar[XB_TOP], 1u);
            const unsigned tg = og / nx;
            if (og + 1u == (tg + 1u) * nx) xb_add(&bar[XB_TOPGEN], 1u);
            else XB_SPIN(xb_ld(&bar[XB_TOPGEN]) == tg, bar);
            __builtin_amdgcn_fence(__ATOMIC_ACQUIRE, "agent");
            xb_add(&bar[XB_XGEN(b.x)], 1u);
            asm volatile("s_waitcnt vmcnt(0)" ::: "memory");
        } else {
            XB_SPIN(xb_ld(&bar[XB_XGEN(b.x)]) == gen, bar);
            __builtin_amdgcn_fence(__ATOMIC_ACQUIRE, "agent");
            asm volatile("s_waitcnt vmcnt(0)" ::: "memory");
        }
    }
    __syncthreads();
}

__device__ __forceinline__ float bf2f(unsigned short b) { return __uint_as_float(((unsigned)b) << 16); }
__device__ __forceinline__ float bflo(unsigned w) { return __uint_as_float(w << 16); }
__device__ __forceinline__ float bfhi(unsigned w) { return __uint_as_float(w & 0xffff0000u); }
__device__ __forceinline__ unsigned short f2bf(float f) { return (unsigned short)(cvt_pk_bf16(f, 0.f) & 0xffffu); }
__device__ __forceinline__ float ssf(unsigned long long v) { return (float)v * (1.f / 1048576.f); }
__device__ __forceinline__ float ex2(float x) { return __builtin_amdgcn_exp2f(x); }
__device__ __forceinline__ float sigmoidf_(float x) { return __builtin_amdgcn_rcpf(1.f + ex2(-x * LOG2E)); }
__device__ __forceinline__ float siluf_(float x) { return x * sigmoidf_(x); }
__device__ __forceinline__ float wave_sum(float v) {
#pragma unroll
    for (int o = 1; o < 64; o <<= 1) v += __shfl_xor(v, o);
    return v;
}
__device__ __forceinline__ float wave_max(float v) {
#pragma unroll
    for (int o = 1; o < 64; o <<= 1) v = fmaxf(v, __shfl_xor(v, o));
    return v;
}
__device__ __forceinline__ float sum32(float v) {
#pragma unroll
    for (int o = 1; o < 32; o <<= 1) v += __shfl_xor(v, o);
    return v;
}
__device__ __forceinline__ int otid() { int t = threadIdx.x; asm volatile("" : "+v"(t)); return t; }
__device__ __forceinline__ int obx() { int b = blockIdx.x; asm volatile("" : "+s"(b)); return b; }
__device__ __forceinline__ int pos_of_row(int row) { return row < NPROMPT ? (row & 4095) : (row & 8191); }
__device__ __forceinline__ int crow(int r, int hi) { return (r & 3) + 8 * (r >> 2) + 4 * hi; }
__device__ __forceinline__ f32x16 mfma32(bf16x8 a, bf16x8 b, f32x16 c) { return __builtin_amdgcn_mfma_f32_32x32x16_bf16(a, b, c, 0, 0, 0); }
__device__ __forceinline__ v4i16 trrd(ldsp p) { return __builtin_amdgcn_ds_read_tr16_b64_v4i16((LAS v4i16*)p); }
__device__ __forceinline__ bf16x8 tr_frag(ldsp p, int off2) { const v4i16 a = trrd(p), b = trrd(p + off2); return (bf16x8){a[0], a[1], a[2], a[3], b[0], b[1], b[2], b[3]}; }
__device__ __forceinline__ bf16x8 pack8(float a, float b, float c, float d, float e, float f, float g, float h) {
    u32x4 w; w.x = cvt_pk_bf16(a, b); w.y = cvt_pk_bf16(c, d); w.z = cvt_pk_bf16(e, f); w.w = cvt_pk_bf16(g, h); return __builtin_bit_cast(bf16x8, w);
}

typedef float f32x2p __attribute__((ext_vector_type(2)));
__device__ __forceinline__ f32x2p swiglu2(f32x2p g, f32x2p u, float kneg, float r2) {
    const f32x2p t = g * kneg;
    f32x2p e; e.x = ex2(t.x); e.y = ex2(t.y);
    const f32x2p d = e + 1.0f;
    f32x2p r; r.x = __builtin_amdgcn_rcpf(d.x); r.y = __builtin_amdgcn_rcpf(d.y);
    return (g * u) * (r * r2);
}
struct EpiSwiglu {
    static constexpr bool PERM = true, AFTER_DRAIN = false; bf16_t* H; const unsigned long long* ss;
    __device__ __forceinline__ void operator()(const f32x4 (&acc)[2][2][4][2], const Unit& u, int wr, int wc, int fr, int fq) const {
        const int row0 = u.pm * 256 + wr * 64 + fr, col0 = u.pn * 128 + wc * 32 + 8 * fq;
#pragma unroll
        for (int ai = 0; ai < 2; ++ai)
#pragma unroll
            for (int m = 0; m < 4; ++m) {
                bf16_t* rp = H + (size_t)(row0 + ai * 128 + m * 16) * DFF + col0;
                const float rstd = __builtin_amdgcn_rsqf(ssf(ss[row0 + ai * 128 + m * 16]) * (1.f / D) + EPS);
                const float kneg = -rstd * LOG2E, r2 = rstd * rstd;
                const f32x4 g0 = acc[ai][0][m][0], g1 = acc[ai][0][m][1], u0 = acc[ai][1][m][0], u1 = acc[ai][1][m][1];
                const f32x2p a = swiglu2((f32x2p){g0[0], g0[1]}, (f32x2p){u0[0], u0[1]}, kneg, r2), b = swiglu2((f32x2p){g0[2], g0[3]}, (f32x2p){u0[2], u0[3]}, kneg, r2);
                const f32x2p c = swiglu2((f32x2p){g1[0], g1[1]}, (f32x2p){u1[0], u1[1]}, kneg, r2), d = swiglu2((f32x2p){g1[2], g1[3]}, (f32x2p){u1[2], u1[3]}, kneg, r2);
                u32x4 w; w.x = cvt_pk_bf16(a.x, a.y); w.y = cvt_pk_bf16(b.x, b.y); w.z = cvt_pk_bf16(c.x, c.y); w.w = cvt_pk_bf16(d.x, d.y);
                *(u32x4*)rp = w;
                asm volatile("" ::: "memory");
            }
    }
};
__device__ __forceinline__ void store8(bf16_t* p, const float (&v)[8]) {
    u32x4 w; w.x = cvt_pk_bf16(v[0], v[1]); w.y = cvt_pk_bf16(v[2], v[3]); w.z = cvt_pk_bf16(v[4], v[5]); w.w = cvt_pk_bf16(v[6], v[7]); *(u32x4*)p = w;
}
template <int MODE> struct EpiResid {
    static constexpr bool PERM = true, AFTER_DRAIN = false; const float* baseA; const float* baseB; float* out; float scale; bf16_t* XB; unsigned long long* ss;
    __device__ __forceinline__ void operator()(const f32x4 (&acc)[2][2][4][2], const Unit& u, int wr, int wc, int fr, int fq) const {
        const int row0 = u.pm * 256 + wr * 64 + fr, col0 = u.pn * 256 + wc * 32 + 8 * fq;
        const float* bp = (u.pm < 64) ? baseA + (size_t)row0 * D : baseB + (size_t)(row0 - NPROMPT) * D;
        float* op = out + (size_t)row0 * D;
        bf16_t* xp = XB + (size_t)row0 * D;
#pragma unroll
        for (int ai = 0; ai < 2; ++ai)
#pragma unroll
            for (int m = 0; m < 4; ++m) {
                const size_t ro = (size_t)(ai * 128 + m * 16) * D + col0;
                float sq = 0.f;
#pragma unroll
                for (int bj = 0; bj < 2; ++bj) {
                    f32x4 b0, b1;
                    if (MODE == 0) { b0 = *(const f32x4*)(bp + ro + bj * 128); b1 = *(const f32x4*)(bp + ro + bj * 128 + 4); }
                    else { const u32x4 w = *(const u32x4*)(xp + ro + bj * 128);
                        b0 = (f32x4){bflo(w.x), bfhi(w.x), bflo(w.y), bfhi(w.y)}; b1 = (f32x4){bflo(w.z), bfhi(w.z), bflo(w.w), bfhi(w.w)}; }
                    const f32x4 y0 = b0 + acc[ai][bj][m][0] * scale, y1 = b1 + acc[ai][bj][m][1] * scale;
                    if (MODE == 2) { *(f32x4*)(op + ro + bj * 128) = y0; *(f32x4*)(op + ro + bj * 128 + 4) = y1; }
                    else {
                        u32x4 w; w.x = cvt_pk_bf16(y0[0], y0[1]); w.y = cvt_pk_bf16(y0[2], y0[3]); w.z = cvt_pk_bf16(y1[0], y1[1]); w.w = cvt_pk_bf16(y1[2], y1[3]);
                        *(u32x4*)(xp + ro + bj * 128) = w;
                        sq += (y0[0] * y0[0] + y0[1] * y0[1]) + (y0[2] * y0[2] + y0[3] * y0[3]) + (y1[0] * y1[0] + y1[1] * y1[1]) + (y1[2] * y1[2] + y1[3] * y1[3]);
                    }
                }
                if (MODE != 2) { sq += __shfl_xor(sq, 16); sq += __shfl_xor(sq, 32); if (fq == 0) atomicAdd(ss + row0 + ai * 128 + m * 16, (unsigned long long)(sq * 1048576.f + 0.5f)); }
                asm volatile("" ::: "memory");
            }
    }
};
template <int KIND> struct EpiAB {
    static constexpr bool PERM = true, AFTER_DRAIN = false;
    bf16_t *QU, *K0, *V0, *SG, *U; const float* tab0; const unsigned long long* ss;
    __device__ __forceinline__ void operator()(const f32x4 (&acc)[2][2][4][2], const Unit& u, int wr, int wc, int fr, int fq) const {
        const int pn = u.pn + 4 * KIND, rowb = u.pm * 256 + wr * 64 + fr;
        if constexpr (KIND == 0) {
            const int head = 2 * (pn & 1) + (wc >> 1), i0 = 32 * (wc & 1) + 8 * fq;
            bf16_t* dst = pn < 2 ? QU : K0; const int ld = pn < 2 ? 1024 : 512; const float sc = pn < 2 ? 1.f : 0.08838834764831845f;
#pragma unroll
            for (int ai = 0; ai < 2; ++ai)
#pragma unroll
                for (int m = 0; m < 4; ++m) {
                    const int row = rowb + ai * 128 + m * 16, s = pos_of_row(row);
                    const float rs = __builtin_amdgcn_rsqf(ssf(ss[row]) * (1.f / D) + EPS) * sc;
                    const f32x4* tp = (const f32x4*)(tab0 + ((size_t)s * 64 + i0) * 2);
                    float o1[8], o2[8];
#pragma unroll
                    for (int n = 0; n < 2; ++n) {
                        const f32x4 ta = tp[2 * n], tb = tp[2 * n + 1]; const f32x4 x1 = acc[ai][0][m][n] * rs, x2 = acc[ai][1][m][n] * rs;
                        o1[4 * n + 0] = x1[0] * ta[0] - x2[0] * ta[1]; o2[4 * n + 0] = x2[0] * ta[0] + x1[0] * ta[1];
                        o1[4 * n + 1] = x1[1] * ta[2] - x2[1] * ta[3]; o2[4 * n + 1] = x2[1] * ta[2] + x1[1] * ta[3];
                        o1[4 * n + 2] = x1[2] * tb[0] - x2[2] * tb[1]; o2[4 * n + 2] = x2[2] * tb[0] + x1[2] * tb[1];
                        o1[4 * n + 3] = x1[3] * tb[2] - x2[3] * tb[3]; o2[4 * n + 3] = x2[3] * tb[2] + x1[3] * tb[3];
                    }
                    bf16_t* rp = dst + (size_t)row * ld + 128 * head + i0;
                    store8(rp, o1); store8(rp + 64, o2); asm volatile("" ::: "memory");
                }
        } else if constexpr (KIND == 1) {
            bf16_t* dst = pn < 6 ? V0 : SG; const bool act = pn >= 6; const int col0 = 256 * (pn & 1) + wc * 32 + 8 * fq;
#pragma unroll
            for (int ai = 0; ai < 2; ++ai)
#pragma unroll
                for (int m = 0; m < 4; ++m) {
                    const int row = rowb + ai * 128 + m * 16;
                    const float rs = __builtin_amdgcn_rsqf(ssf(ss[row]) * (1.f / D) + EPS);
#pragma unroll
                    for (int bj = 0; bj < 2; ++bj) {
                        float v[8];
#pragma unroll
                        for (int n = 0; n < 2; ++n)
#pragma unroll
                            for (int j = 0; j < 4; ++j) { const float x = acc[ai][bj][m][n][j] * rs; v[4 * n + j] = act ? siluf_(x) : x; }
                        store8(dst + (size_t)row * 512 + col0 + 128 * bj, v);
                    }
                    asm volatile("" ::: "memory");
                }
        } else {
            const int col0 = 128 * (pn - 8) + wc * 32 + 8 * fq;
#pragma unroll
            for (int ai = 0; ai < 2; ++ai)
#pragma unroll
                for (int m = 0; m < 4; ++m) {
                    const int row = rowb + ai * 128 + m * 16;
                    const float rs = __builtin_amdgcn_rsqf(ssf(ss[row]) * (1.f / D) + EPS);
                    float v[8];
#pragma unroll
                    for (int n = 0; n < 2; ++n)
#pragma unroll
                        for (int j = 0; j < 4; ++j) v[4 * n + j] = acc[ai][0][m][n][j] * rs * sigmoidf_(acc[ai][1][m][n][j] * rs);
                    store8(U + (size_t)row * 512 + col0, v); asm volatile("" ::: "memory");
                }
        }
    }
};
struct EpiABAll {
    static constexpr bool PERM = true, AFTER_DRAIN = false;
    bf16_t *QU, *K0, *V0, *SG, *U; const float* tab0; const unsigned long long* ss;
    __device__ __forceinline__ void operator()(const f32x4 (&acc)[2][2][4][2], const Unit& u, int wr, int wc, int fr, int fq) const {
        Unit v = u;
        if (u.pn < 4) { EpiAB<0>{QU, K0, V0, SG, U, tab0, ss}(acc, v, wr, wc, fr, fq); }
        else if (u.pn < 8) { v.pn = u.pn - 4; EpiAB<1>{QU, K0, V0, SG, U, tab0, ss}(acc, v, wr, wc, fr, fq); }
        else { v.pn = u.pn - 8; EpiAB<2>{QU, K0, V0, SG, U, tab0, ss}(acc, v, wr, wc, fr, fq); }
    }
};
struct EpiC {
    static constexpr bool PERM = true, AFTER_DRAIN = false;
    bf16_t *Q1, *K1, *V1; const float* tab1; const float* qg; const float* kg; const unsigned long long* ss;
    __device__ __forceinline__ void operator()(const f32x4 (&acc)[2][2][4][2], const Unit& u, int wr, int wc, int fr, int fq) const {
        const int pn = u.pn, rowb = u.pm * 256 + wr * 64 + fr;
        if (pn < 8) {
            const int group = 4 * (pn & 3) + wc, i0 = 8 * fq;
            bf16_t* dst = pn < 4 ? Q1 : K1; const float* gp = pn < 4 ? qg : kg; const float sc = pn < 4 ? 0.125f * LOG2E : 1.f;
            float g1[8], g2[8];
#pragma unroll
            for (int j = 0; j < 8; ++j) { g1[j] = gp[i0 + j] * sc; g2[j] = gp[32 + i0 + j] * sc; }
#pragma unroll
            for (int ai = 0; ai < 2; ++ai)
#pragma unroll
                for (int m = 0; m < 4; ++m) {
                    const int row = rowb + ai * 128 + m * 16, s = pos_of_row(row);
                    const float rs0 = __builtin_amdgcn_rsqf(ssf(ss[row]) * (1.f / D) + EPS);
                    float sq = 0.f;
#pragma unroll
                    for (int bj = 0; bj < 2; ++bj)
#pragma unroll
                        for (int n = 0; n < 2; ++n) { const f32x4 x = acc[ai][bj][m][n] * rs0; sq += (x[0] * x[0] + x[1] * x[1]) + (x[2] * x[2] + x[3] * x[3]); }
                    sq += __shfl_xor(sq, 16); sq += __shfl_xor(sq, 32);
                    const float rstd = __builtin_amdgcn_rsqf(sq * (1.f / 64.f) + EPS) * rs0;
                    const f32x4* tp = (const f32x4*)(tab1 + ((size_t)s * 32 + i0) * 2);
                    float o1[8], o2[8];
#pragma unroll
                    for (int n = 0; n < 2; ++n) {
                        const f32x4 ta = tp[2 * n], tb = tp[2 * n + 1]; f32x4 x1 = acc[ai][0][m][n] * rstd, x2 = acc[ai][1][m][n] * rstd;
#pragma unroll
                        for (int j = 0; j < 4; ++j) { x1[j] *= g1[4 * n + j]; x2[j] *= g2[4 * n + j]; }
                        o1[4 * n + 0] = x1[0] * ta[0] - x2[0] * ta[1]; o2[4 * n + 0] = x2[0] * ta[0] + x1[0] * ta[1];
                        o1[4 * n + 1] = x1[1] * ta[2] - x2[1] * ta[3]; o2[4 * n + 1] = x2[1] * ta[2] + x1[1] * ta[3];
                        o1[4 * n + 2] = x1[2] * tb[0] - x2[2] * tb[1]; o2[4 * n + 2] = x2[2] * tb[0] + x1[2] * tb[1];
                        o1[4 * n + 3] = x1[3] * tb[2] - x2[3] * tb[3]; o2[4 * n + 3] = x2[3] * tb[2] + x1[3] * tb[3];
                    }
                    bf16_t* rp = dst + (size_t)row * 1024 + 64 * group + i0;
                    store8(rp, o1); store8(rp + 32, o2); asm volatile("" ::: "memory");
                }
        } else {
            const int col0 = 256 * (pn - 8) + wc * 32 + 8 * fq;
#pragma unroll
            for (int ai = 0; ai < 2; ++ai)
#pragma unroll
                for (int m = 0; m < 4; ++m) {
                    const int row = rowb + ai * 128 + m * 16;
                    const float rs = __builtin_amdgcn_rsqf(ssf(ss[row]) * (1.f / D) + EPS);
#pragma unroll
                    for (int bj = 0; bj < 2; ++bj) {
                        float v[8];
#pragma unroll
                        for (int n = 0; n < 2; ++n)
#pragma unroll
                            for (int j = 0; j < 4; ++j) v[4 * n + j] = acc[ai][bj][m][n][j] * rs;
                        store8(V1 + (size_t)row * 1024 + col0 + 128 * bj, v);
                    }
                    asm volatile("" ::: "memory");
                }
        }
    }
};

__device__ __forceinline__ int perm_col(int ptype, int np) {
    const int pn = np >> 8, bj = (np >> 7) & 1, t = np & 127;
    if (ptype == 1) return bj * DFF + 128 * pn + t;
    if (ptype == 2) {
        if (pn < 4) { const int base = (pn < 2) ? 0 : 512, pl = pn & 1; return base + 256 * pl + 128 * (t >> 6) + 64 * bj + (t & 63); }
        if (pn < 8) return np;
        return 2048 + 512 * bj + 128 * (pn - 8) + t;
    }
    if (ptype == 3) {
        if (pn < 8) { const int base = (pn < 4) ? 0 : 1024, pl = pn & 3; return base + 64 * (4 * pl + (t >> 5)) + 32 * bj + (t & 31); }
        return np;
    }
    return np;
}
__device__ __forceinline__ void transpose_item(const float* W, int K, int N, int ptype, bf16_t* WT, LAS float* scr, int item, int lane, const float* gain) {
    const int nblk = N / 32, kb = item / nblk, nb = item % nblk, k0 = 64 * kb, n0 = perm_col(ptype, 32 * nb);
    float wv[32];
#pragma unroll
    for (int i = 0; i < 32; ++i) { const int kk = 2 * i + (lane >> 5); wv[i] = W[(size_t)(k0 + kk) * N + n0 + (lane & 31)]; }
    const float g0 = gain ? gain[k0 + (lane >> 5) + 2 * (lane & 31)] : 1.f;
#pragma unroll
    for (int i = 0; i < 32; ++i) { const int kk = 2 * i + (lane >> 5); scr[kk * 33 + (lane & 31)] = wv[i] * __shfl(g0, i + (lane & 32)); }
    asm volatile("s_waitcnt lgkmcnt(0)" ::: "memory");
    const int c = lane & 7;
#pragma unroll
    for (int j = 0; j < 4; ++j) { const int n = (lane >> 3) + 8 * j; const LAS float* s = scr + (8 * c) * 33 + n;
        u32x4 o; o.x = cvt_pk_bf16(s[0 * 33], s[1 * 33]); o.y = cvt_pk_bf16(s[2 * 33], s[3 * 33]); o.z = cvt_pk_bf16(s[4 * 33], s[5 * 33]); o.w = cvt_pk_bf16(s[6 * 33], s[7 * 33]);
        *(u32x4*)(WT + (size_t)(32 * nb + n) * K + k0 + 8 * c) = o; }
    asm volatile("s_waitcnt lgkmcnt(0)" ::: "memory");
}
__device__ __forceinline__ void rms_row_to_bf16(const float* xrow, float* ssrow, bf16_t* orow, int lane) {
    const f32x4* xr = (const f32x4*)xrow + lane;
    f32x4 v[4]; float s = 0.f;
#pragma unroll
    for (int j = 0; j < 4; ++j) { v[j] = xr[64 * j]; s += (v[j][0] * v[j][0] + v[j][1] * v[j][1]) + (v[j][2] * v[j][2] + v[j][3] * v[j][3]); }
    const float tot = wave_sum(s);
    if (lane == 0) *ssrow = tot;
    unsigned long long* o8 = (unsigned long long*)orow + lane;
#pragma unroll
    for (int j = 0; j < 4; ++j) { const f32x4 y = v[j];
        o8[64 * j] = (unsigned long long)cvt_pk_bf16(y[0], y[1]) | ((unsigned long long)cvt_pk_bf16(y[2], y[3]) << 32); }
}
__device__ __forceinline__ void norm_phase(const float* xA, const float* xB, unsigned long long* ss, bf16_t* XN, int gw, int lane) {
    for (int m0 = gw; m0 < M; m0 += 4 * 2048) {
        f32x4 v[4][4];
#pragma unroll
        for (int q = 0; q < 4; ++q) { const int m = m0 + 2048 * q; const float* xr = m < NPROMPT ? xA + (size_t)m * D : xB + (size_t)(m - NPROMPT) * D;
#pragma unroll
            for (int j = 0; j < 4; ++j) v[q][j] = ((const f32x4*)xr + lane)[64 * j]; }
#pragma unroll
        for (int q = 0; q < 4; ++q) { const int m = m0 + 2048 * q; float s = 0.f;
#pragma unroll
            for (int j = 0; j < 4; ++j) s += (v[q][j][0] * v[q][j][0] + v[q][j][1] * v[q][j][1]) + (v[q][j][2] * v[q][j][2] + v[q][j][3] * v[q][j][3]);
            const float tot = wave_sum(s);
            if (lane == 0) ss[m] = (unsigned long long)(tot * 1048576.f + 0.5f);
            unsigned long long* o8 = (unsigned long long*)(XN + (size_t)m * D) + lane;
#pragma unroll
            for (int j = 0; j < 4; ++j) o8[64 * j] = (unsigned long long)cvt_pk_bf16(v[q][j][0], v[q][j][1]) | ((unsigned long long)cvt_pk_bf16(v[q][j][2], v[q][j][3]) << 32); }
    }
}
__device__ __forceinline__ void rope_entry(float* tab, int half, int idx) {
    const int s = idx / half, i = idx % half;
    const float inv = exp2f(-(float)i / (float)half * 13.287712379549449f);
    const float ang = (float)s * inv;
    const double a = (double)ang;
    const double k = rint(a * 0.15915494309189535);
    double r = fma(-k, 6.283185307179586, a); r = fma(-k, 2.4492935982947064e-16, r);
    const float rf = (float)r;
    tab[2 * (size_t)idx] = cosf(rf); tab[2 * (size_t)idx + 1] = sinf(rf);
}

__device__ __forceinline__ void r1_unit(ldsp lds, int uidx, const bf16_t* K0, const bf16_t* V0, bf16_t* KV, float lgf2, float lgb2) {
    const int tid = otid(), lane = tid & 63, wid = __builtin_amdgcn_readfirstlane(tid >> 6), r32 = lane & 31, hi = lane >> 5;
    const int gc = uidx >> 2, h = uidx & 3, r0 = gc * 128;
    ldsp Kimg = lds, Vf = lds + 40960, Vb = lds + 81920;
#pragma unroll
    for (int i = 0; i < 4; ++i) {
        const int cidx = tid + 512 * i, key = cidx >> 4, ch = cidx & 15;
        const u32x4 kv = *(const u32x4*)(K0 + (size_t)(r0 + key) * 512 + 128 * h + 8 * ch);
        const u32x4 vv = *(const u32x4*)(V0 + (size_t)(r0 + key) * 512 + 128 * h + 8 * ch);
        *(LAS u32x4*)(Kimg + key * 320 + ch * 16) = kv;
        const float df = ex2(lgf2 * (float)(127 - key)), db = ex2(lgb2 * (float)key);
        u32x4 wf, wb;
        wf.x = cvt_pk_bf16(bflo(vv.x) * df, bfhi(vv.x) * df); wf.y = cvt_pk_bf16(bflo(vv.y) * df, bfhi(vv.y) * df);
        wf.z = cvt_pk_bf16(bflo(vv.z) * df, bfhi(vv.z) * df); wf.w = cvt_pk_bf16(bflo(vv.w) * df, bfhi(vv.w) * df);
        wb.x = cvt_pk_bf16(bflo(vv.x) * db, bfhi(vv.x) * db); wb.y = cvt_pk_bf16(bflo(vv.y) * db, bfhi(vv.y) * db);
        wb.z = cvt_pk_bf16(bflo(vv.z) * db, bfhi(vv.z) * db); wb.w = cvt_pk_bf16(bflo(vv.w) * db, bfhi(vv.w) * db);
        *(LAS u32x4*)(Vf + key * 320 + ch * 16) = wf;
        *(LAS u32x4*)(Vb + key * 320 + ch * 16) = wb;
    }
    __syncthreads();
    const int dir = wid >> 2, dblk = wid & 3;
    ldsp Vimg = dir ? Vb : Vf;
    const int trow = (lane & 15) >> 2, tcol = 16 * ((lane >> 4) & 1) + 4 * (lane & 3);
    f32x16 acc[4];
#pragma unroll
    for (int eb = 0; eb < 4; ++eb)
#pragma unroll
        for (int r = 0; r < 16; ++r) acc[eb][r] = 0.f;
#pragma unroll
    for (int s = 0; s < 8; ++s) {
        const int krow = 16 * s + 8 * hi + trow;
        const bf16x8 af = tr_frag(Kimg + krow * 320 + (32 * dblk + tcol) * 2, 4 * 320);
#pragma unroll
        for (int eb = 0; eb < 4; ++eb) {
            const bf16x8 bfr = tr_frag(Vimg + krow * 320 + (32 * eb + tcol) * 2, 4 * 320);
            acc[eb] = mfma32(af, bfr, acc[eb]);
        }
    }
    bf16_t* op = KV + (size_t)(uidx * 2 + dir) * 16384 + (size_t)(32 * dblk) * 128;
    __syncthreads();
    ldsp st = lds + wid * 8704;
#pragma unroll
    for (int eb = 0; eb < 4; ++eb)
#pragma unroll
        for (int r = 0; r < 16; ++r) ((LAS unsigned short*)(st + crow(r, hi) * 272))[32 * eb + r32] = f2bf(acc[eb][r]);
    asm volatile("s_waitcnt lgkmcnt(0)" ::: "memory");
#pragma unroll
    for (int i = 0; i < 8; ++i) { const int idx = lane + 64 * i, row = idx >> 4, ch = idx & 15;
        *(u32x4*)(op + row * 128 + 8 * ch) = *(const LAS u32x4*)(st + row * 272 + ch * 16); }
    __syncthreads();
}
__device__ __forceinline__ void conv_tile(ldsp lds, int tile, const bf16_t* U, const float* cw, const float* cb, const float* cg, bf16_t* QU) {
    const int tid = otid(), lane = tid & 63, wid = __builtin_amdgcn_readfirstlane(tid >> 6);
    const int t0 = tile * 32;
    const int seq_lo = t0 < NPROMPT ? (t0 & ~4095) : (t0 & ~8191), seq_hi = seq_lo + (t0 < NPROMPT ? 4096 : 8192);
    LAS unsigned short* Ut = (LAS unsigned short*)lds;
    LAS float* Y = (LAS float*)(lds + 65536);
    LAS float* part = (LAS float*)(lds + 65536 + 65536);
    for (int cidx = tid; cidx < 62 * 64; cidx += 512) {
        const int rr = cidx >> 6, ch = cidx & 63, grow = t0 - 15 + rr;
        u32x4 v = (u32x4){0u, 0u, 0u, 0u};
        if (grow >= seq_lo && grow < seq_hi) v = *(const u32x4*)(U + (size_t)grow * 512 + 8 * ch);
        *(LAS u32x4*)(lds + rr * 1024 + ch * 16) = v;
    }
    float w[31];
#pragma unroll
    for (int k = 0; k < 31; ++k) w[k] = cw[k * 512 + tid];
    const float bias = cb[tid];
    __syncthreads();
    float xin[62];
#pragma unroll
    for (int k = 0; k < 62; ++k) xin[k] = bf2f(Ut[k * 512 + tid]);
#pragma unroll
    for (int tt = 0; tt < 32; ++tt) {
        float y = bias;
#pragma unroll
        for (int k = 0; k < 31; ++k) y += xin[tt + k] * w[k];
        Y[tt * 512 + tid] = y;
    }
    __syncthreads();
#pragma unroll
    for (int i = 0; i < 4; ++i) {
        const int cidx = tid + 512 * i, tt = cidx >> 6, ch = cidx & 63;
        const f32x4 y0 = *(const LAS f32x4*)(Y + tt * 512 + 8 * ch), y1 = *(const LAS f32x4*)(Y + tt * 512 + 8 * ch + 4);
        const float ss = wave_sum((y0[0] * y0[0] + y0[1] * y0[1]) + (y0[2] * y0[2] + y0[3] * y0[3]) + (y1[0] * y1[0] + y1[1] * y1[1]) + (y1[2] * y1[2] + y1[3] * y1[3]));
        const float rstd = __builtin_amdgcn_rsqf(ss * (1.f / 512.f) + EPS);
        const f32x4 g0 = *(const f32x4*)(cg + 8 * ch), g1 = *(const f32x4*)(cg + 8 * ch + 4);
        u32x4 w;
        w.x = cvt_pk_bf16(siluf_(y0[0] * rstd * g0[0]), siluf_(y0[1] * rstd * g0[1])); w.y = cvt_pk_bf16(siluf_(y0[2] * rstd * g0[2]), siluf_(y0[3] * rstd * g0[3]));
        w.z = cvt_pk_bf16(siluf_(y1[0] * rstd * g1[0]), siluf_(y1[1] * rstd * g1[1])); w.w = cvt_pk_bf16(siluf_(y1[2] * rstd * g1[2]), siluf_(y1[3] * rstd * g1[3]));
        *(u32x4*)(QU + (size_t)(t0 + tt) * 1024 + 512 + 8 * ch) = w;
    }
    __syncthreads();
}
__device__ __forceinline__ void scan_phase(bf16_t* KV, const float* decay, int gtid) {
    if (gtid >= 98304) return;
    const int v = gtid & 2047, rest = gtid >> 11, dir = rest & 1, h = (rest >> 1) & 3, seq = rest >> 3;
    const int nc = seq < 4 ? 32 : 64, gc0 = seq < 4 ? seq * 32 : 128 + (seq - 4) * 64;
    const float lg = -expf(decay[dir * 4 + h]);
    const float cd = expf(lg * 128.f);
    float st[8];
#pragma unroll
    for (int j = 0; j < 8; ++j) st[j] = 0.f;
    for (int b = 0; b < nc; b += 8) {
        u32x4 buf[8];
#pragma unroll
        for (int i = 0; i < 8; ++i) { const int lc = dir ? (nc - 1 - (b + i)) : (b + i);
            buf[i] = *(const u32x4*)(KV + ((size_t)((gc0 + lc) * 4 + h) * 2 + dir) * 16384 + v * 8); }
#pragma unroll
        for (int i = 0; i < 8; ++i) { const int lc = dir ? (nc - 1 - (b + i)) : (b + i);
            u32x4 o; o.x = cvt_pk_bf16(st[0], st[1]); o.y = cvt_pk_bf16(st[2], st[3]); o.z = cvt_pk_bf16(st[4], st[5]); o.w = cvt_pk_bf16(st[6], st[7]);
            *(u32x4*)(KV + ((size_t)((gc0 + lc) * 4 + h) * 2 + dir) * 16384 + v * 8) = o;
            st[0] = st[0] * cd + bflo(buf[i].x); st[1] = st[1] * cd + bfhi(buf[i].x); st[2] = st[2] * cd + bflo(buf[i].y); st[3] = st[3] * cd + bfhi(buf[i].y);
            st[4] = st[4] * cd + bflo(buf[i].z); st[5] = st[5] * cd + bfhi(buf[i].z); st[6] = st[6] * cd + bflo(buf[i].w); st[7] = st[7] * cd + bfhi(buf[i].w); }
    }
}
__device__ __forceinline__ void r3_unit(ldsp lds, int uidx, bf16_t* QU, const bf16_t* K0, const bf16_t* V0, const bf16_t* SG, const bf16_t* KV, const float* retg, float lgf2, float lgb2) {
    const int tid = otid(), lane = tid & 63, wid = __builtin_amdgcn_readfirstlane(tid >> 6), r32 = lane & 31, hi = lane >> 5;
    const int gc = uidx >> 2, h = uidx & 3, r0 = gc * 128;
    const int qb = wid & 3, eh = wid >> 2;
    ldsp bufA = lds, bufB = lds + 34816, bufC = lds + 75776; LAS float* ssx = (LAS float*)(lds + 116736);
    bf16x8 qf[8];
    { const bf16_t* qp = QU + (size_t)(r0 + 32 * qb + r32) * 1024 + 128 * h + 8 * hi;
#pragma unroll
      for (int s = 0; s < 8; ++s) qf[s] = *(const bf16x8*)(qp + 16 * s); }
#pragma unroll
    for (int i = 0; i < 4; ++i) {
        const int cidx = tid + 512 * i, key = cidx >> 4, ch = cidx & 15;
        *(LAS u32x4*)(bufA + key * 272 + ch * 16) = *(const u32x4*)(K0 + (size_t)(r0 + key) * 512 + 128 * h + 8 * ch);
        *(LAS u32x4*)(bufB + key * 320 + ch * 16) = *(const u32x4*)(KV + (size_t)(uidx * 2 + 0) * 16384 + key * 128 + 8 * ch);
        *(LAS u32x4*)(bufC + key * 320 + ch * 16) = *(const u32x4*)(KV + (size_t)(uidx * 2 + 1) * 16384 + key * 128 + 8 * ch);
    }
    __syncthreads();
    const int trow = (lane & 15) >> 2, tcol = 16 * ((lane >> 4) & 1) + 4 * (lane & 3);
    f32x16 ot[2];
    {
        f32x16 af[2], ab[2];
#pragma unroll
        for (int e2 = 0; e2 < 2; ++e2)
#pragma unroll
            for (int r = 0; r < 16; ++r) { af[e2][r] = 0.f; ab[e2][r] = 0.f; }
#pragma unroll
        for (int s = 0; s < 8; ++s) {
            const int drow = 16 * s + 8 * hi + trow;
#pragma unroll
            for (int e2 = 0; e2 < 2; ++e2) {
                const int eb = 2 * eh + e2;
                const bf16x8 f1 = tr_frag(bufB + drow * 320 + (32 * eb + tcol) * 2, 4 * 320);
                af[e2] = mfma32(qf[s], f1, af[e2]);
                const bf16x8 f2 = tr_frag(bufC + drow * 320 + (32 * eb + tcol) * 2, 4 * 320);
                ab[e2] = mfma32(qf[s], f2, ab[e2]);
            }
        }
#pragma unroll
        for (int r = 0; r < 16; ++r) {
            const int irow = 32 * qb + crow(r, hi);
            const float sf = ex2(lgf2 * (float)(irow + 1)), sb = ex2(lgb2 * (float)(128 - irow));
#pragma unroll
            for (int e2 = 0; e2 < 2; ++e2) ot[e2][r] = af[e2][r] * sf + ab[e2][r] * sb;
        }
    }
    __syncthreads();
#pragma unroll
    for (int i = 0; i < 4; ++i) {
        const int cidx = tid + 512 * i, key = cidx >> 4, ch = cidx & 15;
        *(LAS u32x4*)(bufB + key * 320 + ch * 16) = *(const u32x4*)(V0 + (size_t)(r0 + key) * 512 + 128 * h + 8 * ch);
    }
    __syncthreads();
    {
        f32x16 p[4];
#pragma unroll
        for (int kb = 0; kb < 4; ++kb)
#pragma unroll
            for (int r = 0; r < 16; ++r) p[kb][r] = 0.f;
#pragma unroll
        for (int s = 0; s < 8; ++s)
#pragma unroll
            for (int kb = 0; kb < 4; ++kb) {
                const bf16x8 a = *(const LAS bf16x8*)(bufA + (32 * kb + r32) * 272 + (16 * s + 8 * hi) * 2);
                p[kb] = mfma32(a, qf[s], p[kb]);
            }
        const int iq = 32 * qb + r32;
        bf16x8 pa[8];
#pragma unroll
        for (int kb = 0; kb < 4; ++kb) {
#pragma unroll
            for (int r = 0; r < 16; ++r) {
                const int j = 32 * kb + crow(r, hi), dl = iq - j;
                const float wgt = dl >= 0 ? ex2(lgf2 * (float)dl) : ex2(lgb2 * (float)(-dl));
                p[kb][r] *= wgt;
            }
            pa[2 * kb] = pack8(p[kb][0], p[kb][1], p[kb][2], p[kb][3], p[kb][4], p[kb][5], p[kb][6], p[kb][7]);
            pa[2 * kb + 1] = pack8(p[kb][8], p[kb][9], p[kb][10], p[kb][11], p[kb][12], p[kb][13], p[kb][14], p[kb][15]);
        }
#pragma unroll
        for (int ks = 0; ks < 8; ++ks) {
            const int vrow = 16 * ks + 4 * hi + trow;
#pragma unroll
            for (int e2 = 0; e2 < 2; ++e2) {
                const int eb = 2 * eh + e2;
                const bf16x8 vf = tr_frag(bufB + vrow * 320 + (32 * eb + tcol) * 2, 8 * 320);
                ot[e2] = mfma32(pa[ks], vf, ot[e2]);
            }
        }
    }
#pragma unroll
    for (int r = 0; r < 16; ++r) {
        float ss = ot[0][r] * ot[0][r] + ot[1][r] * ot[1][r];
        ss = sum32(ss);
        if (r32 == 0) ssx[(qb * 32 + crow(r, hi)) * 2 + eh] = ss;
    }
    __syncthreads();
    ldsp st = lds + wid * 8704;
    const float rg0 = retg[128 * h + 64 * eh + r32], rg1 = retg[128 * h + 64 * eh + 32 + r32];
#pragma unroll
    for (int r = 0; r < 16; ++r) {
        const int lr = qb * 32 + crow(r, hi);
        const float rstd = __builtin_amdgcn_rsqf((ssx[lr * 2] + ssx[lr * 2 + 1]) * (1.f / 128.f) + EPS);
        LAS float* sp = (LAS float*)(st + crow(r, hi) * 272) + r32;
        sp[0] = ot[0][r] * rstd * rg0; sp[32] = ot[1][r] * rstd * rg1;
    }
    asm volatile("s_waitcnt lgkmcnt(0)" ::: "memory");
#pragma unroll
    for (int i = 0; i < 4; ++i) {
        const int idx = lane + 64 * i, row = idx >> 3, ch = idx & 7;
        const f32x4 a = *(const LAS f32x4*)(st + row * 272 + ch * 32), b = *(const LAS f32x4*)(st + row * 272 + ch * 32 + 16);
        const size_t grow = (size_t)(r0 + qb * 32 + row); const int col = 128 * h + 64 * eh + 8 * ch;
        const u32x4 g = *(const u32x4*)(SG + grow * 512 + col);
        u32x4 w; w.x = cvt_pk_bf16(a[0] * bflo(g.x), a[1] * bfhi(g.x)); w.y = cvt_pk_bf16(a[2] * bflo(g.y), a[3] * bfhi(g.y));
        w.z = cvt_pk_bf16(b[0] * bflo(g.z), b[1] * bfhi(g.z)); w.w = cvt_pk_bf16(b[2] * bflo(g.w), b[3] * bfhi(g.w));
        *(u32x4*)(QU + grow * 1024 + col) = w;
    }
    __syncthreads();
}

__device__ __forceinline__ float shx(float v, int lane, int o) { return __builtin_bit_cast(float, __builtin_amdgcn_ds_bpermute((lane ^ o) << 2, __builtin_bit_cast(int, v))); }
__device__ __forceinline__ void glds16(const void* gsrc, unsigned lds_dst) { unsigned keep;
    asm volatile("s_mov_b32 %0, m0\n\ts_mov_b32 m0, %2\n\ts_nop 0\n\tglobal_load_lds_dwordx4 %1, off\n\ts_mov_b32 m0, %0" : "=&s"(keep) : "v"(gsrc), "s"(lds_dst) : "memory"); }
__device__ __forceinline__ unsigned dma_off(int y, int P) { const int row = y / P, cw = y - P * row; return (unsigned)(row * 1024 + (cw < 16 ? cw : 15) * 8) * 2u; }
__device__ __forceinline__ void glds16s(const void* gbase, unsigned voff, unsigned lds_dst) { unsigned keep;
    asm volatile("s_mov_b32 %0, m0\n\ts_mov_b32 m0, %3\n\ts_nop 0\n\tglobal_load_lds_dwordx4 %1, %2\n\ts_mov_b32 m0, %0" : "=&s"(keep) : "v"(voff), "s"(gbase), "s"(lds_dst) : "memory"); }
#define ATTN_DMA(KOFS, VOFS, KT_BASE, VT_BASE) do { \
        const unsigned l0_ = (unsigned)(uintptr_t)lds + 1024u * (unsigned)wid; \
        glds16s(KT_BASE, dk0, l0_ + (KOFS)); glds16s(KT_BASE, dk1, l0_ + (KOFS) + 8192u); if (wid == 0) glds16s(KT_BASE, dk2, l0_ + (KOFS) + 16384u); \
        glds16s(VT_BASE, dv0, l0_ + (VOFS)); glds16s(VT_BASE, dv1, l0_ + (VOFS) + 8192u); if (wid < 4) glds16s(VT_BASE, dv2, l0_ + (VOFS) + 16384u); } while (0)
__device__ __forceinline__ void attn_phase(ldsp lds, const bf16_t* Q1, const bf16_t* K1, const bf16_t* V1, bf16_t* O,
                                           const float* lamp, const float* subg, int vcu) {
    const int wid = __builtin_amdgcn_readfirstlane(otid() >> 6);
    float lam_full;
    { const int lane = otid() & 63; const float la = wave_sum(lamp[lane] * lamp[64 + lane]), lb = wave_sum(lamp[128 + lane] * lamp[192 + lane]);
      lam_full = __builtin_bit_cast(float, __builtin_amdgcn_readfirstlane(__builtin_bit_cast(int, expf(la) - expf(lb) + LINIT1))); }
    for (int ui = 0; ui < 4; ++ui) {
        const int u = vcu + 256 * (ui & 1);
        int S, row0, head, qb;
        if (ui < 2) { S = 4096; row0 = (u >> 7) * 4096; head = (u >> 4) & 7; qb = u & 15; }
        else { S = 8192; row0 = NPROMPT + (u >> 8) * 8192; head = (u >> 5) & 7; qb = u & 31; }
        const int NT = S / 64;
        const int qrow0 = row0 + qb * 256 + wid * 32;
        ldsp Qw = lds + 77824 + wid * 8704;
        { const int lane = otid() & 63;
#pragma unroll
          for (int i = 0; i < 8; ++i) { const int idx = lane + 64 * i, row = idx >> 4, ch = idx & 15;
              *(LAS u32x4*)(Qw + row * 272 + ch * 16) = *(const u32x4*)(Q1 + (size_t)(qrow0 + row) * 1024 + 128 * head + 8 * ch); } }
        const bf16_t* kbase = K1 + (size_t)row0 * 1024 + 128 * head; const bf16_t* vbase = V1 + (size_t)row0 * 1024 + 128 * head;
        f32x16 o[2][4];
#pragma unroll
        for (int c = 0; c < 2; ++c)
#pragma unroll
            for (int eb = 0; eb < 4; ++eb)
#pragma unroll
                for (int r = 0; r < 16; ++r) o[c][eb][r] = 0.f;
        float l0 = 0.f, l1 = 0.f;
        unsigned dk0, dk1, dk2, dv0, dv1, dv2;
        { const int lane = otid() & 63; dk0 = dma_off(64 * wid + lane, 17); dk1 = dma_off(64 * (wid + 8) + lane, 17); dk2 = dma_off(64 * 16 + lane, 17);
          dv0 = dma_off(64 * wid + lane, 20); dv1 = dma_off(64 * (wid + 8) + lane, 20); dv2 = dma_off(64 * (wid + 16) + lane, 20); }
        ATTN_DMA(0u, 34816u, kbase, vbase);
        asm volatile("s_waitcnt vmcnt(0)" ::: "memory");
        __syncthreads();
        for (int kt = 0; kt < NT; ++kt) {
            const int cur = kt & 1;
            const bool more = (kt + 1 < NT);
            const int tid = otid(), lane = tid & 63, r32 = lane & 31, hi = lane >> 5;
            const int trow = (lane & 15) >> 2, tcol = 16 * ((lane >> 4) & 1) + 4 * (lane & 3);
            ldsp Kb = lds + cur * 17408 + r32 * 272 + 16 * hi, Vb = lds + 34816 + cur * 20480 + (4 * hi + trow) * 320 + tcol * 2;
            ldsp qrd = Qw + r32 * 272 + 16 * hi;
            if (more) ATTN_DMA((unsigned)(cur ^ 1) * 17408u, 34816u + (unsigned)(cur ^ 1) * 20480u, kbase + (size_t)(kt + 1) * 64 * 1024, vbase + (size_t)(kt + 1) * 64 * 1024);
#define SBAR_ __builtin_amdgcn_sched_barrier(0)
#define SQL(C, S) do { kf0[S] = *(const LAS bf16x8*)(Kb + (64 * (C) + 16 * (S)) * 2); kf1[S] = *(const LAS bf16x8*)(Kb + 32 * 272 + (64 * (C) + 16 * (S)) * 2); \
        qfv[S] = *(const LAS bf16x8*)(qrd + (64 * (C) + 16 * (S)) * 2); } while (0)
#define SQM(S, P0, P1) do { __builtin_amdgcn_s_setprio(1); P0 = mfma32(kf0[S], qfv[S], P0); P1 = mfma32(kf1[S], qfv[S], P1); __builtin_amdgcn_s_setprio(0); } while (0)
#define SQT(C, P0, P1, HOOK) do { _Pragma("unroll") for (int r = 0; r < 16; ++r) { P0[r] = 0.f; P1[r] = 0.f; } \
        SQL(C, 1); SBAR_; SQM(0, P0, P1); SQL(C, 2); SBAR_; SQM(1, P0, P1); SQL(C, 3); SBAR_; SQM(2, P0, P1); HOOK; SBAR_; SQM(3, P0, P1); SBAR_; } while (0)
#define VFL2(VF, KS, H) do { VF[2 * (H)] = tr_frag(Vb + 16 * (KS) * 320 + 64 * (2 * (H)), 8 * 320); VF[2 * (H) + 1] = tr_frag(Vb + 16 * (KS) * 320 + 64 * (2 * (H) + 1), 8 * 320); } while (0)
#define VFL(VF, KS) do { VFL2(VF, KS, 0); VFL2(VF, KS, 1); } while (0)
#define VWORK(P, B, G, W, RS) do { const float e0_ = ex2(P[(B) + 2 * (G)]), e1_ = ex2(P[(B) + 2 * (G) + 1]); RS += e0_ + e1_; W[G] = cvt_pk_bf16(e0_, e1_); } while (0)
#define GRP(OC, WCUR, VFCUR, VFNEXT, KSNEXT, P, B, WNEXT, RS, PRE) do { __builtin_amdgcn_s_setprio(1); \
        OC[0] = mfma32(__builtin_bit_cast(bf16x8, WCUR), VFCUR[0], OC[0]); if (PRE) VFL2(VFNEXT, KSNEXT, 0); VWORK(P, B, 0, WNEXT, RS); SBAR_; \
        OC[1] = mfma32(__builtin_bit_cast(bf16x8, WCUR), VFCUR[1], OC[1]); VWORK(P, B, 1, WNEXT, RS); SBAR_; \
        OC[2] = mfma32(__builtin_bit_cast(bf16x8, WCUR), VFCUR[2], OC[2]); if (PRE) VFL2(VFNEXT, KSNEXT, 1); VWORK(P, B, 2, WNEXT, RS); SBAR_; \
        OC[3] = mfma32(__builtin_bit_cast(bf16x8, WCUR), VFCUR[3], OC[3]); VWORK(P, B, 3, WNEXT, RS); __builtin_amdgcn_s_setprio(0); SBAR_; } while (0)
            {
                f32x16 pA0, pA1, pB0, pB1; u32x4 wA, wB; bf16x8 vfA[4], vfB[4], kf0[4], kf1[4], qfv[4];
                SQL(0, 0); SBAR_;
                SQT(0, pA0, pA1, (void)0);
                VFL(vfA, 0);
                VWORK(pA0, 0, 0, wA, l0); VWORK(pA0, 0, 1, wA, l0); VWORK(pA0, 0, 2, wA, l0); VWORK(pA0, 0, 3, wA, l0); SBAR_;
                GRP(o[0], wA, vfA, vfB, 1, pA0, 8, wB, l0, true);
                GRP(o[0], wB, vfB, vfA, 2, pA1, 0, wA, l0, true);
                GRP(o[0], wA, vfA, vfB, 3, pA1, 8, wB, l0, false);
                SQL(1, 0); SBAR_;
                SQT(1, pB0, pB1, VFL(vfB, 3));
                GRP(o[0], wB, vfB, vfA, 0, pB0, 0, wA, l1, true);
                GRP(o[1], wA, vfA, vfB, 1, pB0, 8, wB, l1, true);
                GRP(o[1], wB, vfB, vfA, 2, pB1, 0, wA, l1, true);
                GRP(o[1], wA, vfA, vfB, 3, pB1, 8, wB, l1, true);
#pragma unroll
                for (int eb = 0; eb < 4; ++eb) o[1][eb] = mfma32(__builtin_bit_cast(bf16x8, wB), vfB[eb], o[1][eb]);
                SBAR_;
            }
#undef SQT
#undef SQL
#undef SQM
#undef VFL
#undef VWORK
#undef GRP
#undef SBAR_
            asm volatile("s_waitcnt vmcnt(0)" ::: "memory");
            __syncthreads();
        }
        {
            const int lane = otid() & 63, r32 = lane & 31, hi = lane >> 5;
            LAS float* lsc = (LAS float*)(lds + 75776) + wid * 64;
            l0 += shx(l0, lane, 32); l1 += shx(l1, lane, 32);
            if (hi == 0) { lsc[r32] = l0; lsc[32 + r32] = l1; }
            asm volatile("s_waitcnt lgkmcnt(0)" ::: "memory");
            const float g0 = subg[r32], g1 = subg[32 + r32], g2 = subg[64 + r32], g3 = subg[96 + r32];
#pragma unroll
            for (int r = 0; r < 16; ++r) {
                const int lr = crow(r, hi);
                const float i0 = __builtin_amdgcn_rcpf(lsc[lr]), i1 = lam_full * __builtin_amdgcn_rcpf(lsc[32 + lr]);
                const float v0 = o[0][0][r] * i0 - o[1][0][r] * i1, v1 = o[0][1][r] * i0 - o[1][1][r] * i1;
                const float v2 = o[0][2][r] * i0 - o[1][2][r] * i1, v3 = o[0][3][r] * i0 - o[1][3][r] * i1;
                float ss = (v0 * v0 + v1 * v1) + (v2 * v2 + v3 * v3);
                ss += shx(ss, lane, 1); ss += shx(ss, lane, 2); ss += shx(ss, lane, 4); ss += shx(ss, lane, 8); ss += shx(ss, lane, 16);
                const float rstd = __builtin_amdgcn_rsqf(ss * (1.f / 128.f) + EPS) * (1.f - LINIT1);
                LAS unsigned short* sp = (LAS unsigned short*)(Qw + lr * 272) + r32;
                sp[0] = f2bf(v0 * rstd * g0); sp[32] = f2bf(v1 * rstd * g1); sp[64] = f2bf(v2 * rstd * g2); sp[96] = f2bf(v3 * rstd * g3);
            }
            asm volatile("s_waitcnt lgkmcnt(0)" ::: "memory");
#pragma unroll
            for (int i = 0; i < 8; ++i) { const int idx = lane + 64 * i, row = idx >> 4, ch = idx & 15;
                *(u32x4*)(O + (size_t)(qrow0 + row) * 1024 + 128 * head + 8 * ch) = *(const LAS u32x4*)(Qw + row * 272 + ch * 16); }
            asm volatile("s_waitcnt lgkmcnt(0)" ::: "memory");
        }
    }
}

struct Args { const float* in[18]; float* out; unsigned char* ws; int ph_lo, ph_hi; };
constexpr int N_PHASES = 17;

template <class Epi>
__device__ __forceinline__ void run_gemm(ldsp lds, const bf16_t* A, const bf16_t* Bt, int N, int K, const Epi& E) {
    pg8::Gemm g{A, Bt, M, N, K}; pg8::StaticOrder S; S.init(M, N, 256, obx());
#ifndef NO_GEMM
    pg8::gemm_phase<Epi, pg8::StaticOrder, true, true>(lds, g, S, E);
#endif
}
#define WSP(off) ((bf16_t*)(a.ws + (off)))
#define SSP(k) ((unsigned long long*)(a.ws + WS_SS) + (size_t)(k) * M)
__device__ __forceinline__ void ph_prologue(const Args& a, ldsp lds) {
    const int tid = otid(), lane = tid & 63, wid = __builtin_amdgcn_readfirstlane(tid >> 6), bx = obx(), gw = bx * 8 + wid;
    LAS float* scr = (LAS float*)(lds + wid * 16384);
    constexpr int I_FFI = 16 * 176, I_FFO = 44 * 32, I_IN = 16 * 96, I_OUT = 16 * 32;
    constexpr int NITEMS = 4 * I_FFI + 4 * I_FFO + 2 * I_IN + 2 * I_OUT;
    const float* ng = a.in[2];
    for (int it = gw; it < NITEMS; it += 2048) {
        int r = it;
        if (r < 4 * I_FFI) { const int mi = r / I_FFI; const int gi = (mi >> 1) * 3 + ((mi & 1) ? 2 : 0);
            transpose_item(a.in[3] + (size_t)mi * 1024 * 5632, 1024, 5632, 1, WSP(WS_FFI + mi * W_FFI), scr, r % I_FFI, lane, ng + gi * D); continue; } r -= 4 * I_FFI;
        if (r < 4 * I_FFO) { const int mi = r / I_FFO; transpose_item(a.in[4] + (size_t)mi * 2816 * 1024, 2816, 1024, 0, WSP(WS_FFO + mi * W_FFO), scr, r % I_FFO, lane, nullptr); continue; } r -= 4 * I_FFO;
        if (r < I_IN) { transpose_item(a.in[5], 1024, 3072, 2, WSP(WS_ABI), scr, r, lane, ng + 1 * D); continue; } r -= I_IN;
        if (r < I_IN) { transpose_item(a.in[12], 1024, 3072, 3, WSP(WS_CI), scr, r, lane, ng + 4 * D); continue; } r -= I_IN;
        if (r < I_OUT) { transpose_item(a.in[11], 1024, 1024, 0, WSP(WS_ABO), scr, r, lane, nullptr); continue; } r -= I_OUT;
        transpose_item(a.in[17], 1024, 1024, 0, WSP(WS_CO), scr, r, lane, nullptr);
    }
    float* tab0 = (float*)(a.ws + WS_TAB0); float* tab1 = (float*)(a.ws + WS_TAB1);
    for (int e = bx * 512 + tid; e < 8192 * 96; e += 256 * 512) { if (e < 8192 * 64) rope_entry(tab0, 64, e); else rope_entry(tab1, 32, e - 8192 * 64); }
    for (int e = bx * 512 + tid; e < 5 * M; e += 256 * 512) SSP(1)[e] = 0ull;
    norm_phase(a.in[0], a.in[1], SSP(0), WSP(WS_XN), gw, lane);
}
__device__ __forceinline__ void ph_ffn_in(const Args& a, ldsp lds, int wi, int k) { run_gemm(lds, WSP(WS_XN), WSP(WS_FFI + (size_t)wi * W_FFI), 5632, 1024, EpiSwiglu{WSP(WS_H), SSP(k)}); }
template <int MODE>
__device__ __forceinline__ void ph_ffn_out(const Args& a, ldsp lds, int wi, int k) {
    run_gemm(lds, WSP(WS_H), WSP(WS_FFO + (size_t)wi * W_FFO), 1024, 2816, EpiResid<MODE>{a.in[0], a.in[1], a.out, 0.5f, WSP(WS_XN), SSP(k)});
}
__device__ __forceinline__ void ph_outproj(const Args& a, ldsp lds, size_t aoff, size_t woff, int k) {
    run_gemm(lds, WSP(aoff), WSP(woff), 1024, 1024, EpiResid<1>{a.in[0], a.in[1], a.out, 1.0f, WSP(WS_XN), SSP(k)});
}

__global__ void __launch_bounds__(512, 2) fwd_kernel(Args a_in) {
    extern __shared__ __attribute__((aligned(16))) unsigned char lds_raw[];
    cg::grid_group grid = cg::this_grid();
    ldsp lds = (ldsp)lds_raw;
    const Args& a0 = a_in;
    if (threadIdx.x < 16) ((LAS unsigned*)(lds + LDS_MISC))[threadIdx.x] = 0u;
    __syncthreads();
    XcdBarrier bar = xcd_barrier_post((unsigned*)(a_in.ws + WS_CTL), (volatile LAS unsigned*)(lds + LDS_MISC));
    for (int ph = a0.ph_lo; ph < a0.ph_hi; ++ph) {
        Args a = a0; asm volatile("" : "+s"(a.ws), "+s"(a.out));
        switch (ph) {
        case 0: ph_prologue(a, lds); break;
        case 1: ph_ffn_in(a, lds, 0, 0); break;
        case 2: ph_ffn_out<0>(a, lds, 0, 1); break;
        case 3:
            run_gemm(lds, WSP(WS_XN), WSP(WS_ABI), 3072, 1024, EpiABAll{WSP(WS_QU), WSP(WS_K0), WSP(WS_V0), WSP(WS_SG), WSP(WS_U), (const float*)(a.ws + WS_TAB0), SSP(1)});
            break;
        case 4: {
            const int bx = obx(); const float lgf2 = -expf(a.in[6][(bx & 3)]) * LOG2E, lgb2 = -expf(a.in[6][4 + (bx & 3)]) * LOG2E;
            for (int i = 0; i < 4; ++i) r1_unit(lds, bx + 256 * i, WSP(WS_K0), WSP(WS_V0), (bf16_t*)a.out, lgf2, lgb2);
            for (int i = 0; i < 4; ++i) conv_tile(lds, bx + 256 * i, WSP(WS_U), a.in[8], a.in[9], a.in[10], WSP(WS_QU));
        } break;
        case 5: scan_phase((bf16_t*)a.out, a.in[6], obx() * 512 + otid()); break;
        case 6: {
            const int bx = obx(); const float lgf2 = -expf(a.in[6][(bx & 3)]) * LOG2E, lgb2 = -expf(a.in[6][4 + (bx & 3)]) * LOG2E;
            for (int i = 0; i < 4; ++i) r3_unit(lds, bx + 256 * i, WSP(WS_QU), WSP(WS_K0), WSP(WS_V0), WSP(WS_SG), (bf16_t*)a.out, a.in[7], lgf2, lgb2);
        } break;
        case 7: ph_outproj(a, lds, WS_QU, WS_ABO, 2); break;
        case 8: ph_ffn_in(a, lds, 1, 2); break;
        case 9: ph_ffn_out<1>(a, lds, 1, 3); break;
        case 10: ph_ffn_in(a, lds, 2, 3); break;
        case 11: ph_ffn_out<1>(a, lds, 2, 4); break;
        case 12: run_gemm(lds, WSP(WS_XN), WSP(WS_CI), 3072, 1024, EpiC{WSP(WS_Q1), WSP(WS_K1), WSP(WS_V1), (const float*)(a.ws + WS_TAB1), a.in[13], a.in[14], SSP(4)}); break;
        case 13: {
            const int bx = obx(); const int vcu = (bx % 8) * 32 + bx / 8;
            attn_phase(lds, WSP(WS_Q1), WSP(WS_K1), WSP(WS_V1), WSP(WS_Q1), a.in[15], a.in[16], vcu);
        } break;
        case 14: ph_outproj(a, lds, WS_Q1, WS_CO, 5); break;
        case 15: ph_ffn_in(a, lds, 3, 5); break;
        case 16: ph_ffn_out<2>(a, lds, 3, 0); break;
        default: break;
        }
        if (ph + 1 < a0.ph_hi) { if (a0.ph_hi > 1000) grid.sync(); else xcd_barrier(bar); }
    }
}
}

extern "C" void kernel_launch(void* const* d_in, const int* in_sizes, int n_in, void* d_out, int out_size, void* d_ws, size_t ws_size, hipStream_t stream) {
    static int grid = 0;
    if (grid == 0) {
        if (n_in != 18 || out_size != mk::M * mk::D || ws_size < mk::WS_END) { fprintf(stderr, "kernel_launch: unexpected shapes n_in %d out %d ws %zu\n", n_in, out_size, ws_size); grid = -1; return; }
        int dev = 0, cus = 0, per_cu = 0;
        (void)hipGetDevice(&dev); (void)hipDeviceGetAttribute(&cus, hipDeviceAttributeMultiprocessorCount, dev);
        (void)hipFuncSetAttribute((const void*)mk::fwd_kernel, hipFuncAttributeMaxDynamicSharedMemorySize, mk::LDS_BYTES);
        (void)hipOccupancyMaxActiveBlocksPerMultiprocessor(&per_cu, (const void*)mk::fwd_kernel, 512, mk::LDS_BYTES);
        (void)hipGetLastError();
        grid = cus > 0 ? cus : 256;
        if (grid > 256) grid = 256;
    }
    if (grid < 0) return;
    mk::Args a{};
    for (int i = 0; i < 18; ++i) a.in[i] = (const float*)d_in[i];
    a.out = (float*)d_out; a.ws = (unsigned char*)d_ws; a.ph_lo = 0; a.ph_hi = mk::N_PHASES;
    (void)hipMemsetAsync((char*)d_ws + mk::WS_CTL, 0, mk::CTL_BYTES, stream);
    void* args[] = {&a};
    hipError_t e = hipLaunchCooperativeKernel((const void*)mk::fwd_kernel, dim3(grid), dim3(512), args, mk::LDS_BYTES, stream);
    if (e != hipSuccess) fprintf(stderr, "cooperative launch failed: %s (grid %d)\n", hipGetErrorString(e), grid);
}
```

```cpp
#include <hip/hip_runtime.h>
#include <hip/hip_cooperative_groups.h>
#include <cstdio>
#include <cstdint>
namespace cg = cooperative_groups;
namespace pg8 {
#define PG8_LAS __attribute__((address_space(3)))
typedef unsigned short bf16_t;
typedef short bf16x8 __attribute__((ext_vector_type(8)));
typedef float f32x4 __attribute__((ext_vector_type(4)));
typedef unsigned u32x4 __attribute__((ext_vector_type(4)));
constexpr int BM = 256, BK = 64, HALF = 128, HTB = HALF * BK * 2  , STAGE_BYTES = 8 * HTB, NXCD = 8, WGM = 8;

__host__ __device__ __forceinline__ int lds_byte(int r, int c) { const int st = (r >> 4) * 2 + (c >> 5), rr = r & 15, cc = c & 31, ob = rr * 64 + cc * 2; return st * 1024 + (ob ^ (((ob >> 9) & 1) << 5)); }
__host__ __device__ __forceinline__ void stage_rc(int b, int& R, int& C) { const int st = b / 1024, sb = b % 1024, swz = sb ^ (((sb >> 9) & 1) << 5); R = (st >> 1) * 16 + swz / 64; C = (st & 1) * 32 + (swz % 64) / 2; }
__host__ __device__ __forceinline__ int perm32(int rho) { const int n = rho >> 4, i = rho & 15; return 8 * (i >> 2) + 4 * n + (i & 3); }

struct Unit { int pm, pn; };
struct Gemm { const bf16_t* A; const bf16_t* Bt; int M, N, K; };

struct StaticOrder {
    int nM, nN, nwg, G, c;
    __host__ __device__ void init(int M, int N, int G_, int c_) { nM = M / BM; nN = N / BM; nwg = nM * nN; G = G_; c = c_; }
    __host__ __device__ bool next(int i, Unit& u) const {
        const long L = (long)i * G + c; if (L >= nwg) return false;
        int wgid = (int)L; { const int q = nwg / NXCD, r = nwg % NXCD, xcd = wgid % NXCD, off = wgid / NXCD; wgid = (xcd < r ? xcd * (q + 1) : r * (q + 1) + (xcd - r) * q) + off; }
        const int nig = WGM * nN, gid = wgid / nig, fm = gid * WGM, gsz = (nM - fm) < WGM ? (nM - fm) : WGM;
        u.pm = fm + ((wgid % nig) % gsz); u.pn = (wgid % nig) / gsz; return true;
    }
    __device__ __forceinline__ void a_ready(const Unit&) const {}
    __device__ __forceinline__ void done(const Unit&) const {}
};

typedef float f32x2cv __attribute__((ext_vector_type(2))); typedef __bf16 bf16x2cv __attribute__((ext_vector_type(2)));
__device__ __forceinline__ unsigned cvt_pk_bf16(float lo, float hi) { f32x2cv v = {lo, hi}; bf16x2cv b = __builtin_convertvector(v, bf16x2cv); return __builtin_bit_cast(unsigned, b); }
typedef float f32x2 __attribute__((ext_vector_type(2)));
template <class Epi, class Sched, bool ALIGN_EPI = false, bool SP2 = false>
__device__ __forceinline__ void gemm_phase(PG8_LAS unsigned char* lds, const Gemm g, const Sched& S, const Epi& E) {
    int tid_ = threadIdx.x; asm volatile("" : "+v"(tid_)); const int tid = tid_, wid = __builtin_amdgcn_readfirstlane(tid >> 6), lane = tid & 63, wr = wid >> 2, wc = wid & 3, fr = lane & 15, fq = lane >> 4;
    const int K = g.K, nt = K / BK;
    unsigned voffA[2], voffB[2];
#pragma unroll
    for (int i = 0; i < 2; ++i) { int R, C; stage_rc(tid * 16 + i * 8192, R, C); const int Rb = Epi::PERM ? ((R & ~31) + perm32(R & 31)) : R;
        voffA[i] = (unsigned)(R * K + C) * 2u; voffB[i] = (unsigned)(Rb * K + C) * 2u; }
    const size_t kstep = (size_t)(BK * 2);
    const size_t hstep = (size_t)HALF * K * 2;
    const size_t tstep = 2 * hstep;
    const unsigned ldsw = (unsigned)wid * 1024u;
    const int aoff = lds_byte(wr * 64 + fr, fq * 8), boff = lds_byte(wc * 32 + fr, fq * 8);
#define PG8_SA(b, h) (((b) * 2 + (h)) * HTB)
#define PG8_SB(b, h) ((4 + (b) * 2 + (h)) * HTB)
#define PG8_STAGE(bufoff, gbase, voff) do { _Pragma("unroll") for (int _i = 0; _i < 2; ++_i) \
        __builtin_amdgcn_global_load_lds((const unsigned*)((const char*)(gbase) + (voff)[_i]), (PG8_LAS unsigned*)(lds + (bufoff) + ldsw + _i * 8192), 16, 0, 0); } while (0)
#define PG8_LDA(dst, b, h) do { _Pragma("unroll") for (int m = 0; m < 4; ++m) _Pragma("unroll") for (int k = 0; k < 2; ++k) dst[m][k] = *(const PG8_LAS bf16x8*)(lds + PG8_SA(b, h) + aoff + m * 2048 + k * 1024); } while (0)
#define PG8_LDB(dst, b, h) do { _Pragma("unroll") for (int n = 0; n < 2; ++n) _Pragma("unroll") for (int k = 0; k < 2; ++k) dst[n][k] = *(const PG8_LAS bf16x8*)(lds + PG8_SB(b, h) + boff + n * 2048 + k * 1024); } while (0)
#define PG8_MMA(ai, bj, At, Bt) do { __builtin_amdgcn_s_setprio(1); _Pragma("unroll") for (int m = 0; m < 4; ++m) _Pragma("unroll") for (int n = 0; n < 2; ++n) _Pragma("unroll") for (int k = 0; k < 2; ++k) \
        acc[ai][bj][m][n] = __builtin_amdgcn_mfma_f32_16x16x32_bf16(Bt[n][k], At[m][k], acc[ai][bj][m][n], 0, 0, 0); __builtin_amdgcn_s_setprio(0); } while (0)
#define PG8_WAIT_V(n) asm volatile("s_waitcnt vmcnt(" #n ")" ::: "memory")
#define PG8_WAIT_L(n) asm volatile("s_waitcnt lgkmcnt(" #n ")" ::: "memory")
#define PG8_BAR __builtin_amdgcn_s_barrier()
#define PG8_SCHED __builtin_amdgcn_sched_barrier(0)
    Unit cur, nxt; int ui = 0;
    if (!S.next(0, cur)) return;
    f32x4 acc[2][2][4][2];
#pragma unroll
    for (int a = 0; a < 2; ++a)
#pragma unroll
        for (int b = 0; b < 2; ++b)
#pragma unroll
            for (int m = 0; m < 4; ++m)
#pragma unroll
                for (int n = 0; n < 2; ++n) acc[a][b][m][n] = (f32x4){0.f, 0.f, 0.f, 0.f};
    bf16x8 At[4][2], B0[2][2], B1[2][2];
    const char* cA = (const char*)g.A + (size_t)cur.pm * tstep; const char* cB = (const char*)g.Bt + (size_t)cur.pn * tstep;
    S.a_ready(cur);
    if constexpr (SP2) {
        PG8_STAGE(PG8_SB(0, 0), cB, voffB); PG8_STAGE(PG8_SB(0, 1), cB + hstep, voffB); PG8_STAGE(PG8_SA(0, 0), cA, voffA); PG8_STAGE(PG8_SA(0, 1), cA + hstep, voffA);
        if (wr == 1) PG8_BAR;
        PG8_WAIT_V(2); PG8_BAR;
        PG8_STAGE(PG8_SB(1, 0), cB + kstep, voffB); PG8_STAGE(PG8_SA(1, 0), cA + kstep, voffA); PG8_STAGE(PG8_SB(1, 1), cB + hstep + kstep, voffB);
        PG8_WAIT_V(6); PG8_BAR;
    } else {
        PG8_STAGE(PG8_SB(0, 0), cB, voffB); PG8_STAGE(PG8_SA(0, 0), cA, voffA); PG8_STAGE(PG8_SB(0, 1), cB + hstep, voffB); PG8_STAGE(PG8_SA(0, 1), cA + hstep, voffA);
        if (wr == 1) PG8_BAR;
        PG8_WAIT_V(4); PG8_BAR;
        PG8_STAGE(PG8_SB(1, 0), cB + kstep, voffB); PG8_STAGE(PG8_SA(1, 0), cA + kstep, voffA); PG8_STAGE(PG8_SB(1, 1), cB + hstep + kstep, voffB);
        PG8_WAIT_V(6); PG8_BAR;
    }
    for (;;) {
        const bool has_next = S.next(ui + 1, nxt);
        const char* nA = has_next ? (const char*)g.A + (size_t)nxt.pm * tstep : cA; const char* nB = has_next ? (const char*)g.Bt + (size_t)nxt.pn * tstep : cB;
        for (int t = 0; t < nt; t += 2) {
            const bool last = (t == nt - 2);
            const char* a1 = cA + (size_t)(t + 1) * kstep;
            const char* a2 = last ? nA : cA + (size_t)(t + 2) * kstep; const char* b2 = last ? nB : cB + (size_t)(t + 2) * kstep;
            const char* a3 = a2 + kstep; const char* b3 = b2 + kstep;
            if (last && has_next) S.a_ready(nxt);
            if constexpr (SP2) {
            PG8_LDB(B0, 0, 0); PG8_LDB(B1, 0, 1); PG8_SCHED; PG8_LDA(At, 0, 0); PG8_STAGE(PG8_SA(1, 1), a1 + hstep, voffA);
            PG8_WAIT_V(8); PG8_WAIT_L(0); PG8_BAR; PG8_MMA(0, 0, At, B0); PG8_MMA(0, 1, At, B1); PG8_BAR; PG8_SCHED;
            PG8_LDA(At, 0, 1); PG8_STAGE(PG8_SB(0, 0), b2, voffB); PG8_STAGE(PG8_SB(0, 1), b2 + hstep, voffB); PG8_STAGE(PG8_SA(0, 0), a2, voffA);
            PG8_WAIT_V(8); PG8_WAIT_L(0); PG8_BAR; PG8_MMA(1, 0, At, B0); PG8_MMA(1, 1, At, B1); PG8_BAR; PG8_SCHED;
            PG8_LDB(B0, 1, 0); PG8_LDB(B1, 1, 1); PG8_SCHED; PG8_LDA(At, 1, 0); PG8_STAGE(PG8_SA(0, 1), a2 + hstep, voffA);
            PG8_WAIT_V(8); PG8_WAIT_L(0); PG8_BAR; PG8_MMA(0, 0, At, B0); PG8_MMA(0, 1, At, B1); PG8_BAR; PG8_SCHED;
            PG8_LDA(At, 1, 1); PG8_STAGE(PG8_SB(1, 0), b3, voffB); PG8_STAGE(PG8_SB(1, 1), b3 + hstep, voffB); PG8_STAGE(PG8_SA(1, 0), a3, voffA);
            PG8_WAIT_V(8); PG8_WAIT_L(0); PG8_BAR; PG8_MMA(1, 0, At, B0); PG8_MMA(1, 1, At, B1); PG8_BAR; PG8_SCHED;
            } else {
            PG8_LDB(B0, 0, 0); PG8_SCHED; PG8_LDA(At, 0, 0); PG8_STAGE(PG8_SA(1, 1), a1 + hstep, voffA);
            PG8_WAIT_L(8); PG8_BAR; PG8_WAIT_L(0); PG8_MMA(0, 0, At, B0); PG8_BAR; PG8_SCHED;
            PG8_LDB(B1, 0, 1); PG8_STAGE(PG8_SB(0, 0), b2, voffB);
            PG8_BAR; PG8_WAIT_L(0); PG8_MMA(0, 1, At, B1); PG8_BAR;
            PG8_LDA(At, 0, 1); PG8_STAGE(PG8_SA(0, 0), a2, voffA);
            PG8_BAR; PG8_WAIT_L(0); PG8_MMA(1, 0, At, B0); PG8_BAR; PG8_SCHED;
            PG8_STAGE(PG8_SB(0, 1), b2 + hstep, voffB);
            PG8_WAIT_V(6); PG8_BAR; PG8_MMA(1, 1, At, B1); PG8_BAR;
            PG8_LDB(B0, 1, 0); PG8_SCHED; PG8_LDA(At, 1, 0); PG8_STAGE(PG8_SA(0, 1), a2 + hstep, voffA);
            PG8_WAIT_L(8); PG8_BAR; PG8_WAIT_L(0); PG8_MMA(0, 0, At, B0); PG8_BAR; PG8_SCHED;
            PG8_LDB(B1, 1, 1); PG8_STAGE(PG8_SB(1, 0), b3, voffB);
            PG8_BAR; PG8_WAIT_L(0); PG8_MMA(0, 1, At, B1); PG8_BAR;
            PG8_LDA(At, 1, 1); PG8_STAGE(PG8_SA(1, 0), a3, voffA);
            PG8_BAR; PG8_WAIT_L(0); PG8_MMA(1, 0, At, B0); PG8_BAR; PG8_SCHED;
            PG8_STAGE(PG8_SB(1, 1), b3 + hstep, voffB);
            PG8_WAIT_V(6); PG8_BAR; PG8_MMA(1, 1, At, B1); PG8_BAR;
            }
        }
        if constexpr (ALIGN_EPI) { if (wr == 0) PG8_BAR; }
        if constexpr (!Epi::AFTER_DRAIN) { E(acc, cur, wr, wc, fr, fq); S.done(cur); }
        if (!has_next) break;
#pragma unroll
        for (int a = 0; a < 2; ++a)
#pragma unroll
            for (int b = 0; b < 2; ++b)
#pragma unroll
                for (int m = 0; m < 4; ++m)
#pragma unroll
                    for (int n = 0; n < 2; ++n) acc[a][b][m][n] = (f32x4){0.f, 0.f, 0.f, 0.f};
        cur = nxt; cA = nA; cB = nB; ++ui;
        if constexpr (ALIGN_EPI) { if (wr == 1) PG8_BAR; }
    }
    PG8_WAIT_V(0);
    if constexpr (!ALIGN_EPI) { if (wr == 0) PG8_BAR; }
    PG8_BAR;
    if constexpr (Epi::AFTER_DRAIN) { E.fused(acc, cur, wr, wc, fr, fq, lds, wid, lane); S.done(cur); }
#undef PG8_SA
#undef PG8_SB
#undef PG8_STAGE
#undef PG8_LDA
#undef PG8_LDB
#undef PG8_MMA
#undef PG8_WAIT_V
#undef PG8_WAIT_L
#undef PG8_BAR
#undef PG8_SCHED
}
}

namespace mk {
using pg8::bf16_t; using pg8::bf16x8; using pg8::f32x4; using pg8::u32x4; using pg8::Unit; using pg8::cvt_pk_bf16;
#define LAS __attribute__((address_space(3)))
typedef LAS unsigned char* ldsp;
typedef float f32x16 __attribute__((ext_vector_type(16)));
typedef short v4i16 __attribute__((ext_vector_type(4)));

constexpr int M = 32768, D = 1024, DFF = 2816, NPROMPT = 16384;
constexpr float EPS = 1e-6f, LOG2E = 1.4426950408889634f;
constexpr float LINIT1 = 0.35550906759096924f;
constexpr int LDS_BYTES = 147456 + 64, LDS_MISC = 147456;

constexpr size_t MiB = 1u << 20;
constexpr size_t WS_TAB0 = 0, WS_TAB1 = 4 * MiB;
constexpr size_t WS_SS = 6 * MiB;
constexpr size_t WS_CTL = 7 * MiB + 768 * 1024, CTL_BYTES = 16384;
constexpr size_t WS_W = 8 * MiB;
constexpr size_t W_FFI = (size_t)5632 * 1024 * 2, W_FFO = (size_t)1024 * 2816 * 2, W_IN = (size_t)3072 * 1024 * 2, W_OUT = (size_t)1024 * 1024 * 2;
constexpr size_t WS_FFI = WS_W, WS_FFO = WS_FFI + 4 * W_FFI, WS_ABI = WS_FFO + 4 * W_FFO, WS_CI = WS_ABI + W_IN, WS_ABO = WS_CI + W_IN, WS_CO = WS_ABO + W_OUT;
constexpr size_t WS_XN = 90 * MiB;
constexpr size_t WS_BIG = 154 * MiB;
constexpr size_t WS_H = WS_BIG;
constexpr size_t WS_QU = WS_BIG, WS_K0 = WS_BIG + 64 * MiB, WS_V0 = WS_BIG + 96 * MiB, WS_SG = WS_BIG + 128 * MiB, WS_U = WS_BIG + 160 * MiB;
constexpr size_t WS_Q1 = WS_BIG, WS_K1 = WS_BIG + 64 * MiB, WS_V1 = WS_BIG + 128 * MiB;
constexpr size_t WS_END = 346 * MiB;
static_assert(WS_CO + W_OUT <= WS_XN, "weights fit");
static_assert(WS_H + (size_t)M * DFF * 2 <= WS_END, "h fits");

#define XB_TMO      128
#define XB_XCNT(j)  (256  + 64 * (j))
#define XB_XSUB(j)  (1280 + 64 * (j))
#define XB_XGEN(j)  (2304 + 64 * (j))
#define XB_TOP      3328
#define XB_TOPGEN   3392
#define XCD_BAR_WORDS 3456
#define XB_SPIN_CAP (1u << 18)

__device__ __forceinline__ unsigned xb_ld(unsigned* p)              { return __hip_atomic_load(p, __ATOMIC_RELAXED, __HIP_MEMORY_SCOPE_AGENT); }
__device__ __forceinline__ unsigned xb_add(unsigned* p, unsigned v) { return __hip_atomic_fetch_add(p, v, __ATOMIC_RELAXED, __HIP_MEMORY_SCOPE_AGENT); }
__device__ __forceinline__ unsigned xb_xcc_id() { return (unsigned)__builtin_amdgcn_s_getreg((3 << 11) | 20) & 0xFu; }
#define XB_SPIN(cond, bar) do { unsigned _sp = 0; while (cond) { __builtin_amdgcn_s_sleep(1); \
    if ((++_sp & 255u) == 0u) { if (xb_ld(&(bar)[XB_TMO])) break; if (_sp > XB_SPIN_CAP) { atomicAdd(&(bar)[XB_TMO], 1u); break; } } } } while (0)

struct XcdBarrier {
    unsigned* bar; unsigned x;
    volatile LAS unsigned* st;
};

__device__ __forceinline__ XcdBarrier xcd_barrier_post(unsigned* bar, volatile LAS unsigned* st) {
    XcdBarrier b; b.bar = bar; b.x = xb_xcc_id(); b.st = st;
    if (threadIdx.x == 0) (void)xb_add(&bar[XB_XCNT(b.x)], 1u);
    return b;
}
__device__ __forceinline__ void xcd_barrier_complete(unsigned* bar, unsigned x, unsigned& nloc, unsigned& nx) {
    const unsigned G = gridDim.x * gridDim.y * gridDim.z;
    unsigned sum, cnt, mine, sp = 0u;
    for (;;) {
        sum = 0u; cnt = 0u; mine = 0u;
#pragma unroll
        for (unsigned j = 0; j < 16; ++j) { const unsigned c = xb_ld(&bar[XB_XCNT(j)]); sum += c; cnt += (c > 0u) ? 1u : 0u; mine = (j == x) ? c : mine; }
        if (sum == G) break;
        __builtin_amdgcn_s_sleep(1);
        if ((++sp & 255u) == 0u) { if (xb_ld(&bar[XB_TMO])) break; if (sp > XB_SPIN_CAP) { atomicAdd(&bar[XB_TMO], 1u); break; } }
    }
    nloc = mine > 0u ? mine : 1u; nx = cnt > 0u ? cnt : 1u;
}

__device__ __forceinline__ void xcd_barrier(const XcdBarrier& b) {
    asm volatile("s_waitcnt vmcnt(0)" ::: "memory");
    __syncthreads();
    if (threadIdx.x == 0) {
        unsigned* bar = b.bar;
        __builtin_amdgcn_s_waitcnt(0);
        unsigned nloc = b.st[0], nx = b.st[1];
        if (nloc == 0u) { xcd_barrier_complete(bar, b.x, nloc, nx); b.st[0] = nloc; b.st[1] = nx; }
        const unsigned old = xb_add(&bar[XB_XSUB(b.x)], 1u);
        const unsigned gen = old / nloc;
        if (old + 1u == (gen + 1u) * nloc) {
            __builtin_amdgcn_fence(__ATOMIC_RELEASE, "agent");
            asm volatile("s_waitcnt vmcnt(0)" ::: "memory");
            const unsigned og = xb_add(&bar[XB_TOP], 1u);
            const unsigned tg = og / nx;
            if (og + 1u == (tg + 1u) * nx) xb_add(&bar[XB_TOPGEN], 1u);
            else XB_SPIN(xb_ld(&bar[XB_TOPGEN]) == tg, bar);
            __builtin_amdgcn_fence(__ATOMIC_ACQUIRE, "agent");
            xb_add(&bar[XB_XGEN(b.x)], 1u);
            asm volatile("s_waitcnt vmcnt(0)" ::: "memory");
        } else {
            XB_SPIN(xb_ld(&bar[XB_XGEN(b.x)]) == gen, bar);
            __builtin_amdgcn_fence(__ATOMIC_ACQUIRE, "agent");
            asm volatile("s_waitcnt vmcnt(0)" ::: "memory");
        }
    }
    __syncthreads();
}

__device__ __forceinline__ float bf2f(unsigned short b) { return __uint_as_float(((unsigned)b) << 16); }
__device__ __forceinline__ float bflo(unsigned w) { return __uint_as_float(w << 16); }
__device__ __forceinline__ float bfhi(unsigned w) { return __uint_as_float(w & 0xffff0000u); }
__device__ __forceinline__ unsigned short f2bf(float f) { return (unsigned short)(cvt_pk_bf16(f, 0.f) & 0xffffu); }
__device__ __forceinline__ float ssf(unsigned long long v) { return (float)v * (1.f / 1048576.f); }
__device__ __forceinline__ float ex2(float x) { return __builtin_amdgcn_exp2f(x); }
__device__ __forceinline__ float sigmoidf_(float x) { return __builtin_amdgcn_rcpf(1.f + ex2(-x * LOG2E)); }
__device__ __forceinline__ float siluf_(float x) { return x * sigmoidf_(x); }
__device__ __forceinline__ float wave_sum(float v) {
#pragma unroll
    for (int o = 1; o < 64; o <<= 1) v += __shfl_xor(v, o);
    return v;
}
__device__ __forceinline__ float wave_max(float v) {
#pragma unroll
    for (int o = 1; o < 64; o <<= 1) v = fmaxf(v, __shfl_xor(v, o));
    return v;
}
__device__ __forceinline__ float sum32(float v) {
#pragma unroll
    for (int o = 1; o < 32; o <<= 1) v += __shfl_xor(v, o);
    return v;
}
__device__ __forceinline__ int otid() { int t = threadIdx.x; asm volatile("" : "+v"(t)); return t; }
__device__ __forceinline__ int obx() { int b = blockIdx.x; asm volatile("" : "+s"(b)); return b; }
__device__ __forceinline__ int pos_of_row(int row) { return row < NPROMPT ? (row & 4095) : (row & 8191); }
__device__ __forceinline__ int crow(int r, int hi) { return (r & 3) + 8 * (r >> 2) + 4 * hi; }
__device__ __forceinline__ f32x16 mfma32(bf16x8 a, bf16x8 b, f32x16 c) { return __builtin_amdgcn_mfma_f32_32x32x16_bf16(a, b, c, 0, 0, 0); }
__device__ __forceinline__ v4i16 trrd(ldsp p) { return __builtin_amdgcn_ds_read_tr16_b64_v4i16((LAS v4i16*)p); }
__device__ __forceinline__ bf16x8 tr_frag(ldsp p, int off2) { const v4i16 a = trrd(p), b = trrd(p + off2); return (bf16x8){a[0], a[1], a[2], a[3], b[0], b[1], b[2], b[3]}; }
__device__ __forceinline__ bf16x8 pack8(float a, float b, float c, float d, float e, float f, float g, float h) {
    u32x4 w; w.x = cvt_pk_bf16(a, b); w.y = cvt_pk_bf16(c, d); w.z = cvt_pk_bf16(e, f); w.w = cvt_pk_bf16(g, h); return __builtin_bit_cast(bf16x8, w);
}

typedef float f32x2p __attribute__((ext_vector_type(2)));
__device__ __forceinline__ f32x2p swiglu2(f32x2p g, f32x2p u, float kneg, float r2) {
    const f32x2p t = g * kneg;
    f32x2p e; e.x = ex2(t.x); e.y = ex2(t.y);
    const f32x2p d = e + 1.0f;
    f32x2p r; r.x = __builtin_amdgcn_rcpf(d.x); r.y = __builtin_amdgcn_rcpf(d.y);
    return (g * u) * (r * r2);
}
struct EpiSwiglu {
    static constexpr bool PERM = true, AFTER_DRAIN = false; bf16_t* H; const unsigned long long* ss;
    __device__ __forceinline__ void operator()(const f32x4 (&acc)[2][2][4][2], const Unit& u, int wr, int wc, int fr, int fq) const {
        const int row0 = u.pm * 256 + wr * 64 + fr, col0 = u.pn * 128 + wc * 32 + 8 * fq;
#pragma unroll
        for (int ai = 0; ai < 2; ++ai)
#pragma unroll
            for (int m = 0; m < 4; ++m) {
                bf16_t* rp = H + (size_t)(row0 + ai * 128 + m * 16) * DFF + col0;
                const float rstd = __builtin_amdgcn_rsqf(ssf(ss[row0 + ai * 128 + m * 16]) * (1.f / D) + EPS);
                const float kneg = -rstd * LOG2E, r2 = rstd * rstd;
                const f32x4 g0 = acc[ai][0][m][0], g1 = acc[ai][0][m][1], u0 = acc[ai][1][m][0], u1 = acc[ai][1][m][1];
                const f32x2p a = swiglu2((f32x2p){g0[0], g0[1]}, (f32x2p){u0[0], u0[1]}, kneg, r2), b = swiglu2((f32x2p){g0[2], g0[3]}, (f32x2p){u0[2], u0[3]}, kneg, r2);
                const f32x2p c = swiglu2((f32x2p){g1[0], g1[1]}, (f32x2p){u1[0], u1[1]}, kneg, r2), d = swiglu2((f32x2p){g1[2], g1[3]}, (f32x2p){u1[2], u1[3]}, kneg, r2);
                u32x4 w; w.x = cvt_pk_bf16(a.x, a.y); w.y = cvt_pk_bf16(b.x, b.y); w.z = cvt_pk_bf16(c.x, c.y); w.w = cvt_pk_bf16(d.x, d.y);
                *(u32x4*)rp = w;
                asm volatile("" ::: "memory");
            }
    }
};
__device__ __forceinline__ void store8(bf16_t* p, const float (&v)[8]) {
    u32x4 w; w.x = cvt_pk_bf16(v[0], v[1]); w.y = cvt_pk_bf16(v[2], v[3]); w.z = cvt_pk_bf16(v[4], v[5]); w.w = cvt_pk_bf16(v[6], v[7]); *(u32x4*)p = w;
}
template <int MODE> struct EpiResid {
    static constexpr bool PERM = true, AFTER_DRAIN = false; const float* baseA; const float* baseB; float* out; float scale; bf16_t* XB; unsigned long long* ss;
    __device__ __forceinline__ void operator()(const f32x4 (&acc)[2][2][4][2], const Unit& u, int wr, int wc, int fr, int fq) const {
        const int row0 = u.pm * 256 + wr * 64 + fr, col0 = u.pn * 256 + wc * 32 + 8 * fq;
        const float* bp = (u.pm < 64) ? baseA + (size_t)row0 * D : baseB + (size_t)(row0 - NPROMPT) * D;
        float* op = out + (size_t)row0 * D;
        bf16_t* xp = XB + (size_t)row0 * D;
#pragma unroll
        for (int ai = 0; ai < 2; ++ai)
#pragma unroll
            for (int m = 0; m < 4; ++m) {
                const size_t ro = (size_t)(ai * 128 + m * 16) * D + col0;
                float sq = 0.f;
#pragma unroll
                for (int bj = 0; bj < 2; ++bj) {
                    f32x4 b0, b1;
                    if (MODE == 0) { b0 = *(const f32x4*)(bp + ro + bj * 128); b1 = *(const f32x4*)(bp + ro + bj * 128 + 4); }
                    else { const u32x4 w = *(const u32x4*)(xp + ro + bj * 128);
                        b0 = (f32x4){bflo(w.x), bfhi(w.x), bflo(w.y), bfhi(w.y)}; b1 = (f32x4){bflo(w.z), bfhi(w.z), bflo(w.w), bfhi(w.w)}; }
                    const f32x4 y0 = b0 + acc[ai][bj][m][0] * scale, y1 = b1 + acc[ai][bj][m][1] * scale;
                    if (MODE == 2) { *(f32x4*)(op + ro + bj * 128) = y0; *(f32x4*)(op + ro + bj * 128 + 4) = y1; }
                    else {
                        u32x4 w; w.x = cvt_pk_bf16(y0[0], y0[1]); w.y = cvt_pk_bf16(y0[2], y0[3]); w.z = cvt_pk_bf16(y1[0], y1[1]); w.w = cvt_pk_bf16(y1[2], y1[3]);
                        *(u32x4*)(xp + ro + bj * 128) = w;
                        sq += (y0[0] * y0[0] + y0[1] * y0[1]) + (y0[2] * y0[2] + y0[3] * y0[3]) + (y1[0] * y1[0] + y1[1] * y1[1]) + (y1[2] * y1[2] + y1[3] * y1[3]);
                    }
                }
                if (MODE != 2) { sq += __shfl_xor(sq, 16); sq += __shfl_xor(sq, 32); if (fq == 0) atomicAdd(ss + row0 + ai * 128 + m * 16, (unsigned long long)(sq * 1048576.f + 0.5f)); }
                asm volatile("" ::: "memory");
            }
    }
};
template <int KIND> struct EpiAB {
    static constexpr bool PERM = true, AFTER_DRAIN = false;
    bf16_t *QU, *K0, *V0, *SG, *U; const float* tab0; const unsigned long long* ss;
    __device__ __forceinline__ void operator()(const f32x4 (&acc)[2][2][4][2], const Unit& u, int wr, int wc, int fr, int fq) const {
        const int pn = u.pn + 4 * KIND, rowb = u.pm * 256 + wr * 64 + fr;
        if constexpr (KIND == 0) {
            const int head = 2 * (pn & 1) + (wc >> 1), i0 = 32 * (wc & 1) + 8 * fq;
            bf16_t* dst = pn < 2 ? QU : K0; const int ld = pn < 2 ? 1024 : 512; const float sc = pn < 2 ? 1.f : 0.08838834764831845f;
#pragma unroll
            for (int ai = 0; ai < 2; ++ai)
#pragma unroll
                for (int m = 0; m < 4; ++m) {
                    const int row = rowb + ai * 128 + m * 16, s = pos_of_row(row);
                    const float rs = __builtin_amdgcn_rsqf(ssf(ss[row]) * (1.f / D) + EPS) * sc;
                    const f32x4* tp = (const f32x4*)(tab0 + ((size_t)s * 64 + i0) * 2);
                    float o1[8], o2[8];
#pragma unroll
                    for (int n = 0; n < 2; ++n) {
                        const f32x4 ta = tp[2 * n], tb = tp[2 * n + 1]; const f32x4 x1 = acc[ai][0][m][n] * rs, x2 = acc[ai][1][m][n] * rs;
                        o1[4 * n + 0] = x1[0] * ta[0] - x2[0] * ta[1]; o2[4 * n + 0] = x2[0] * ta[0] + x1[0] * ta[1];
                        o1[4 * n + 1] = x1[1] * ta[2] - x2[1] * ta[3]; o2[4 * n + 1] = x2[1] * ta[2] + x1[1] * ta[3];
                        o1[4 * n + 2] = x1[2] * tb[0] - x2[2] * tb[1]; o2[4 * n + 2] = x2[2] * tb[0] + x1[2] * tb[1];
                        o1[4 * n + 3] = x1[3] * tb[2] - x2[3] * tb[3]; o2[4 * n + 3] = x2[3] * tb[2] + x1[3] * tb[3];
                    }
                    bf16_t* rp = dst + (size_t)row * ld + 128 * head + i0;
                    store8(rp, o1); store8(rp + 64, o2); asm volatile("" ::: "memory");
                }
        } else if constexpr (KIND == 1) {
            bf16_t* dst = pn < 6 ? V0 : SG; const bool act = pn >= 6; const int col0 = 256 * (pn & 1) + wc * 32 + 8 * fq;
#pragma unroll
            for (int ai = 0; ai < 2; ++ai)
#pragma unroll
                for (int m = 0; m < 4; ++m) {
                    const int row = rowb + ai * 128 + m * 16;
                    const float rs = __builtin_amdgcn_rsqf(ssf(ss[row]) * (1.f / D) + EPS);
#pragma unroll
                    for (int bj = 0; bj < 2; ++bj) {
                        float v[8];
#pragma unroll
                        for (int n = 0; n < 2; ++n)
#pragma unroll
                            for (int j = 0; j < 4; ++j) { const float x = acc[ai][bj][m][n][j] * rs; v[4 * n + j] = act ? siluf_(x) : x; }
                        store8(dst + (size_t)row * 512 + col0 + 128 * bj, v);
                    }
                    asm volatile("" ::: "memory");
                }
        } else {
            const int col0 = 128 * (pn - 8) + wc * 32 + 8 * fq;
#pragma unroll
            for (int ai = 0; ai < 2; ++ai)
#pragma unroll
                for (int m = 0; m < 4; ++m) {
                    const int row = rowb + ai * 128 + m * 16;
                    const float rs = __builtin_amdgcn_rsqf(ssf(ss[row]) * (1.f / D) + EPS);
                    float v[8];
#pragma unroll
                    for (int n = 0; n < 2; ++n)
#pragma unroll
                        for (int j = 0; j < 4; ++j) v[4 * n + j] = acc[ai][0][m][n][j] * rs * sigmoidf_(acc[ai][1][m][n][j] * rs);
                    store8(U + (size_t)row * 512 + col0, v); asm volatile("" ::: "memory");
                }
        }
    }
};
struct EpiABAll {
    static constexpr bool PERM = true, AFTER_DRAIN = false;
    bf16_t *QU, *K0, *V0, *SG, *U; const float* tab0; const unsigned long long* ss;
    __device__ __forceinline__ void operator()(const f32x4 (&acc)[2][2][4][2], const Unit& u, int wr, int wc, int fr, int fq) const {
        Unit v = u;
        if (u.pn < 4) { EpiAB<0>{QU, K0, V0, SG, U, tab0, ss}(acc, v, wr, wc, fr, fq); }
        else if (u.pn < 8) { v.pn = u.pn - 4; EpiAB<1>{QU, K0, V0, SG, U, tab0, ss}(acc, v, wr, wc, fr, fq); }
        else { v.pn = u.pn - 8; EpiAB<2>{QU, K0, V0, SG, U, tab0, ss}(acc, v, wr, wc, fr, fq); }
    }
};
struct EpiC {
    static constexpr bool PERM = true, AFTER_DRAIN = false;
    bf16_t *Q1, *K1, *V1; const float* tab1; const float* qg; const float* kg; const unsigned long long* ss;
    __device__ __forceinline__ void operator()(const f32x4 (&acc)[2][2][4][2], const Unit& u, int wr, int wc, int fr, int fq) const {
        const int pn = u.pn, rowb = u.pm * 256 + wr * 64 + fr;
        if (pn < 8) {
            const int group = 4 * (pn & 3) + wc, i0 = 8 * fq;
            bf16_t* dst = pn < 4 ? Q1 : K1; const float* gp = pn < 4 ? qg : kg; const float sc = pn < 4 ? 0.125f * LOG2E : 1.f;
            float g1[8], g2[8];
#pragma unroll
            for (int j = 0; j < 8; ++j) { g1[j] = gp[i0 + j] * sc; g2[j] = gp[32 + i0 + j] * sc; }
#pragma unroll
            for (int ai = 0; ai < 2; ++ai)
#pragma unroll
                for (int m = 0; m < 4; ++m) {
                    const int row = rowb + ai * 128 + m * 16, s = pos_of_row(row);
                    const float rs0 = __builtin_amdgcn_rsqf(ssf(ss[row]) * (1.f / D) + EPS);
                    float sq = 0.f;
#pragma unroll
                    for (int bj = 0; bj < 2; ++bj)
#pragma unroll
                        for (int n = 0; n < 2; ++n) { const f32x4 x = acc[ai][bj][m][n] * rs0; sq += (x[0] * x[0] + x[1] * x[1]) + (x[2] * x[2] + x[3] * x[3]); }
                    sq += __shfl_xor(sq, 16); sq += __shfl_xor(sq, 32);
                    const float rstd = __builtin_amdgcn_rsqf(sq * (1.f / 64.f) + EPS) * rs0;
                    const f32x4* tp = (const f32x4*)(tab1 + ((size_t)s * 32 + i0) * 2);
                    float o1[8], o2[8];
#pragma unroll
                    for (int n = 0; n < 2; ++n) {
                        const f32x4 ta = tp[2 * n], tb = tp[2 * n + 1]; f32x4 x1 = acc[ai][0][m][n] * rstd, x2 = acc[ai][1][m][n] * rstd;
#pragma unroll
                        for (int j = 0; j < 4; ++j) { x1[j] *= g1[4 * n + j]; x2[j] *= g2[4 * n + j]; }
                        o1[4 * n + 0] = x1[0] * ta[0] - x2[0] * ta[1]; o2[4 * n + 0] = x2[0] * ta[0] + x1[0] * ta[1];
                        o1[4 * n + 1] = x1[1] * ta[2] - x2[1] * ta[3]; o2[4 * n + 1] = x2[1] * ta[2] + x1[1] * ta[3];
                        o1[4 * n + 2] = x1[2] * tb[0] - x2[2] * tb[1]; o2[4 * n + 2] = x2[2] * tb[0] + x1[2] * tb[1];
                        o1[4 * n + 3] = x1[3] * tb[2] - x2[3] * tb[3]; o2[4 * n + 3] = x2[3] * tb[2] + x1[3] * tb[3];
                    }
                    bf16_t* rp = dst + (size_t)row * 1024 + 64 * group + i0;
                    store8(rp, o1); store8(rp + 32, o2); asm volatile("" ::: "memory");
                }
        } else {
            const int col0 = 256 * (pn - 8) + wc * 32 + 8 * fq;
#pragma unroll
            for (int ai = 0; ai < 2; ++ai)
#pragma unroll
                for (int m = 0; m < 4; ++m) {
                    const int row = rowb + ai * 128 + m * 16;
                    const float rs = __builtin_amdgcn_rsqf(ssf(ss[row]) * (1.f / D) + EPS);
#pragma unroll
                    for (int bj = 0; bj < 2; ++bj) {
                        float v[8];
#pragma unroll
                        for (int n = 0; n < 2; ++n)
#pragma unroll
                            for (int j = 0; j < 4; ++j) v[4 * n + j] = acc[ai][bj][m][n][j] * rs;
                        store8(V1 + (size_t)row * 1024 + col0 + 128 * bj, v);
                    }
                    asm volatile("" ::: "memory");
                }
        }
    }
};

__device__ __forceinline__ int perm_col(int ptype, int np) {
    const int pn = np >> 8, bj = (np >> 7) & 1, t = np & 127;
    if (ptype == 1) return bj * DFF + 128 * pn + t;
    if (ptype == 2) {
        if (pn < 4) { const int base = (pn < 2) ? 0 : 512, pl = pn & 1; return base + 256 * pl + 128 * (t >> 6) + 64 * bj + (t & 63); }
        if (pn < 8) return np;
        return 2048 + 512 * bj + 128 * (pn - 8) + t;
    }
    if (ptype == 3) {
        if (pn < 8) { const int base = (pn < 4) ? 0 : 1024, pl = pn & 3; return base + 64 * (4 * pl + (t >> 5)) + 32 * bj + (t & 31); }
        return np;
    }
    return np;
}
__device__ __forceinline__ void transpose_item(const float* W, int K, int N, int ptype, bf16_t* WT, LAS float* scr, int item, int lane, const float* gain) {
    const int nblk = N / 32, kb = item / nblk, nb = item % nblk, k0 = 64 * kb, n0 = perm_col(ptype, 32 * nb);
    f32x4 wv[8];
    const int c4 = lane & 7, kr = lane >> 3;
#pragma unroll
    for (int i = 0; i < 8; ++i) wv[i] = *(const f32x4*)(W + (size_t)(k0 + kr + 8 * i) * N + n0 + 4 * c4);
#pragma unroll
    for (int i = 0; i < 8; ++i) { const int kk = kr + 8 * i; const float g = gain ? gain[k0 + kk] : 1.f;
        scr[kk * 33 + 4 * c4 + 0] = wv[i][0] * g; scr[kk * 33 + 4 * c4 + 1] = wv[i][1] * g; scr[kk * 33 + 4 * c4 + 2] = wv[i][2] * g; scr[kk * 33 + 4 * c4 + 3] = wv[i][3] * g; }
    asm volatile("s_waitcnt lgkmcnt(0)" ::: "memory");
    const int c = lane & 7;
#pragma unroll
    for (int j = 0; j < 4; ++j) { const int n = (lane >> 3) + 8 * j; const LAS float* s = scr + (8 * c) * 33 + n;
        u32x4 o; o.x = cvt_pk_bf16(s[0 * 33], s[1 * 33]); o.y = cvt_pk_bf16(s[2 * 33], s[3 * 33]); o.z = cvt_pk_bf16(s[4 * 33], s[5 * 33]); o.w = cvt_pk_bf16(s[6 * 33], s[7 * 33]);
        *(u32x4*)(WT + (size_t)(32 * nb + n) * K + k0 + 8 * c) = o; }
    asm volatile("s_waitcnt lgkmcnt(0)" ::: "memory");
}
__device__ __forceinline__ void rms_row_to_bf16(const float* xrow, float* ssrow, bf16_t* orow, int lane) {
    const f32x4* xr = (const f32x4*)xrow + lane;
    f32x4 v[4]; float s = 0.f;
#pragma unroll
    for (int j = 0; j < 4; ++j) { v[j] = xr[64 * j]; s += (v[j][0] * v[j][0] + v[j][1] * v[j][1]) + (v[j][2] * v[j][2] + v[j][3] * v[j][3]); }
    const float tot = wave_sum(s);
    if (lane == 0) *ssrow = tot;
    unsigned long long* o8 = (unsigned long long*)orow + lane;
#pragma unroll
    for (int j = 0; j < 4; ++j) { const f32x4 y = v[j];
        o8[64 * j] = (unsigned long long)cvt_pk_bf16(y[0], y[1]) | ((unsigned long long)cvt_pk_bf16(y[2], y[3]) << 32); }
}
__device__ __forceinline__ void norm_phase(const float* xA, const float* xB, unsigned long long* ss, bf16_t* XN, int gw, int lane) {
    for (int m0 = gw; m0 < M; m0 += 4 * 2048) {
        f32x4 v[4][4];
#pragma unroll
        for (int q = 0; q < 4; ++q) { const int m = m0 + 2048 * q; const float* xr = m < NPROMPT ? xA + (size_t)m * D : xB + (size_t)(m - NPROMPT) * D;
#pragma unroll
            for (int j = 0; j < 4; ++j) v[q][j] = ((const f32x4*)xr + lane)[64 * j]; }
#pragma unroll
        for (int q = 0; q < 4; ++q) { const int m = m0 + 2048 * q; float s = 0.f;
#pragma unroll
            for (int j = 0; j < 4; ++j) s += (v[q][j][0] * v[q][j][0] + v[q][j][1] * v[q][j][1]) + (v[q][j][2] * v[q][j][2] + v[q][j][3] * v[q][j][3]);
            const float tot = wave_sum(s);
            if (lane == 0) ss[m] = (unsigned long long)(tot * 1048576.f + 0.5f);
            unsigned long long* o8 = (unsigned long long*)(XN + (size_t)m * D) + lane;
#pragma unroll
            for (int j = 0; j < 4; ++j) o8[64 * j] = (unsigned long long)cvt_pk_bf16(v[q][j][0], v[q][j][1]) | ((unsigned long long)cvt_pk_bf16(v[q][j][2], v[q][j][3]) << 32); }
    }
}
__device__ __forceinline__ void rope_entry(float* tab, int half, int idx) {
    const int s = idx / half, i = idx % half;
    const float inv = exp2f(-(float)i / (float)half * 13.287712379549449f);
    const float ang = (float)s * inv;
    const double a = (double)ang;
    const double k = rint(a * 0.15915494309189535);
    double r = fma(-k, 6.283185307179586, a); r = fma(-k, 2.4492935982947064e-16, r);
    const float rf = (float)r;
    tab[2 * (size_t)idx] = cosf(rf); tab[2 * (size_t)idx + 1] = sinf(rf);
}

__device__ __forceinline__ void r1_unit(ldsp lds, int uidx, const bf16_t* K0, const bf16_t* V0, bf16_t* KV, float lgf2, float lgb2) {
    const int tid = otid(), lane = tid & 63, wid = __builtin_amdgcn_readfirstlane(tid >> 6), r32 = lane & 31, hi = lane >> 5;
    const int gc = uidx >> 2, h = uidx & 3, r0 = gc * 128;
    ldsp Kimg = lds, Vf = lds + 40960, Vb = lds + 81920;
#pragma unroll
    for (int i = 0; i < 4; ++i) {
        const int cidx = tid + 512 * i, key = cidx >> 4, ch = cidx & 15;
        const u32x4 kv = *(const u32x4*)(K0 + (size_t)(r0 + key) * 512 + 128 * h + 8 * ch);
        const u32x4 vv = *(const u32x4*)(V0 + (size_t)(r0 + key) * 512 + 128 * h + 8 * ch);
        *(LAS u32x4*)(Kimg + key * 320 + ch * 16) = kv;
        const float df = ex2(lgf2 * (float)(127 - key)), db = ex2(lgb2 * (float)key);
        u32x4 wf, wb;
        wf.x = cvt_pk_bf16(bflo(vv.x) * df, bfhi(vv.x) * df); wf.y = cvt_pk_bf16(bflo(vv.y) * df, bfhi(vv.y) * df);
        wf.z = cvt_pk_bf16(bflo(vv.z) * df, bfhi(vv.z) * df); wf.w = cvt_pk_bf16(bflo(vv.w) * df, bfhi(vv.w) * df);
        wb.x = cvt_pk_bf16(bflo(vv.x) * db, bfhi(vv.x) * db); wb.y = cvt_pk_bf16(bflo(vv.y) * db, bfhi(vv.y) * db);
        wb.z = cvt_pk_bf16(bflo(vv.z) * db, bfhi(vv.z) * db); wb.w = cvt_pk_bf16(bflo(vv.w) * db, bfhi(vv.w) * db);
        *(LAS u32x4*)(Vf + key * 320 + ch * 16) = wf;
        *(LAS u32x4*)(Vb + key * 320 + ch * 16) = wb;
    }
    __syncthreads();
    const int dir = wid >> 2, dblk = wid & 3;
    ldsp Vimg = dir ? Vb : Vf;
    const int trow = (lane & 15) >> 2, tcol = 16 * ((lane >> 4) & 1) + 4 * (lane & 3);
    f32x16 acc[4];
#pragma unroll
    for (int eb = 0; eb < 4; ++eb)
#pragma unroll
        for (int r = 0; r < 16; ++r) acc[eb][r] = 0.f;
#pragma unroll
    for (int s = 0; s < 8; ++s) {
        const int krow = 16 * s + 8 * hi + trow;
        const bf16x8 af = tr_frag(Kimg + krow * 320 + (32 * dblk + tcol) * 2, 4 * 320);
#pragma unroll
        for (int eb = 0; eb < 4; ++eb) {
            const bf16x8 bfr = tr_frag(Vimg + krow * 320 + (32 * eb + tcol) * 2, 4 * 320);
            acc[eb] = mfma32(af, bfr, acc[eb]);
        }
    }
    bf16_t* op = KV + (size_t)(uidx * 2 + dir) * 16384 + (size_t)(32 * dblk) * 128;
    __syncthreads();
    ldsp st = lds + wid * 8704;
#pragma unroll
    for (int eb = 0; eb < 4; ++eb)
#pragma unroll
        for (int r = 0; r < 16; ++r) ((LAS unsigned short*)(st + crow(r, hi) * 272))[32 * eb + r32] = f2bf(acc[eb][r]);
    asm volatile("s_waitcnt lgkmcnt(0)" ::: "memory");
#pragma unroll
    for (int i = 0; i < 8; ++i) { const int idx = lane + 64 * i, row = idx >> 4, ch = idx & 15;
        *(u32x4*)(op + row * 128 + 8 * ch) = *(const LAS u32x4*)(st + row * 272 + ch * 16); }
    __syncthreads();
}
__device__ __forceinline__ void conv_tile(ldsp lds, int tile, const bf16_t* U, const float* cw, const float* cb, const float* cg, bf16_t* QU) {
    const int tid = otid(), lane = tid & 63, wid = __builtin_amdgcn_readfirstlane(tid >> 6);
    const int t0 = tile * 32;
    const int seq_lo = t0 < NPROMPT ? (t0 & ~4095) : (t0 & ~8191), seq_hi = seq_lo + (t0 < NPROMPT ? 4096 : 8192);
    LAS unsigned short* Ut = (LAS unsigned short*)lds;
    LAS float* Y = (LAS float*)(lds + 65536);
    LAS float* part = (LAS float*)(lds + 65536 + 65536);
    for (int cidx = tid; cidx < 62 * 64; cidx += 512) {
        const int rr = cidx >> 6, ch = cidx & 63, grow = t0 - 15 + rr;
        u32x4 v = (u32x4){0u, 0u, 0u, 0u};
        if (grow >= seq_lo && grow < seq_hi) v = *(const u32x4*)(U + (size_t)grow * 512 + 8 * ch);
        *(LAS u32x4*)(lds + rr * 1024 + ch * 16) = v;
    }
    float w[31];
#pragma unroll
    for (int k = 0; k < 31; ++k) w[k] = cw[k * 512 + tid];
    const float bias = cb[tid];
    __syncthreads();
    float xin[62];
#pragma unroll
    for (int k = 0; k < 62; ++k) xin[k] = bf2f(Ut[k * 512 + tid]);
#pragma unroll
    for (int tt = 0; tt < 32; ++tt) {
        float y = bias;
#pragma unroll
        for (int k = 0; k < 31; ++k) y += xin[tt + k] * w[k];
        Y[tt * 512 + tid] = y;
    }
    __syncthreads();
#pragma unroll
    for (int i = 0; i < 4; ++i) {
        const int cidx = tid + 512 * i, tt = cidx >> 6, ch = cidx & 63;
        const f32x4 y0 = *(const LAS f32x4*)(Y + tt * 512 + 8 * ch), y1 = *(const LAS f32x4*)(Y + tt * 512 + 8 * ch + 4);
        const float ss = wave_sum((y0[0] * y0[0] + y0[1] * y0[1]) + (y0[2] * y0[2] + y0[3] * y0[3]) + (y1[0] * y1[0] + y1[1] * y1[1]) + (y1[2] * y1[2] + y1[3] * y1[3]));
        const float rstd = __builtin_amdgcn_rsqf(ss * (1.f / 512.f) + EPS);
        const f32x4 g0 = *(const f32x4*)(cg + 8 * ch), g1 = *(const f32x4*)(cg + 8 * ch + 4);
        u32x4 w;
        w.x = cvt_pk_bf16(siluf_(y0[0] * rstd * g0[0]), siluf_(y0[1] * rstd * g0[1])); w.y = cvt_pk_bf16(siluf_(y0[2] * rstd * g0[2]), siluf_(y0[3] * rstd * g0[3]));
        w.z = cvt_pk_bf16(siluf_(y1[0] * rstd * g1[0]), siluf_(y1[1] * rstd * g1[1])); w.w = cvt_pk_bf16(siluf_(y1[2] * rstd * g1[2]), siluf_(y1[3] * rstd * g1[3]));
        *(u32x4*)(QU + (size_t)(t0 + tt) * 1024 + 512 + 8 * ch) = w;
    }
    __syncthreads();
}
__device__ __forceinline__ void scan_phase(bf16_t* KV, const float* decay, int gtid) {
    if (gtid >= 98304) return;
    const int v = gtid & 2047, rest = gtid >> 11, dir = rest & 1, h = (rest >> 1) & 3, seq = rest >> 3;
    const int nc = seq < 4 ? 32 : 64, gc0 = seq < 4 ? seq * 32 : 128 + (seq - 4) * 64;
    const float lg = -expf(decay[dir * 4 + h]);
    const float cd = expf(lg * 128.f);
    float st[8];
#pragma unroll
    for (int j = 0; j < 8; ++j) st[j] = 0.f;
    for (int b = 0; b < nc; b += 8) {
        u32x4 buf[8];
#pragma unroll
        for (int i = 0; i < 8; ++i) { const int lc = dir ? (nc - 1 - (b + i)) : (b + i);
            buf[i] = *(const u32x4*)(KV + ((size_t)((gc0 + lc) * 4 + h) * 2 + dir) * 16384 + v * 8); }
#pragma unroll
        for (int i = 0; i < 8; ++i) { const int lc = dir ? (nc - 1 - (b + i)) : (b + i);
            u32x4 o; o.x = cvt_pk_bf16(st[0], st[1]); o.y = cvt_pk_bf16(st[2], st[3]); o.z = cvt_pk_bf16(st[4], st[5]); o.w = cvt_pk_bf16(st[6], st[7]);
            *(u32x4*)(KV + ((size_t)((gc0 + lc) * 4 + h) * 2 + dir) * 16384 + v * 8) = o;
            st[0] = st[0] * cd + bflo(buf[i].x); st[1] = st[1] * cd + bfhi(buf[i].x); st[2] = st[2] * cd + bflo(buf[i].y); st[3] = st[3] * cd + bfhi(buf[i].y);
            st[4] = st[4] * cd + bflo(buf[i].z); st[5] = st[5] * cd + bfhi(buf[i].z); st[6] = st[6] * cd + bflo(buf[i].w); st[7] = st[7] * cd + bfhi(buf[i].w); }
    }
}
__device__ __forceinline__ void r3_unit(ldsp lds, int uidx, bf16_t* QU, const bf16_t* K0, const bf16_t* V0, const bf16_t* SG, const bf16_t* KV, const float* retg, float lgf2, float lgb2) {
    const int tid = otid(), lane = tid & 63, wid = __builtin_amdgcn_readfirstlane(tid >> 6), r32 = lane & 31, hi = lane >> 5;
    const int gc = uidx >> 2, h = uidx & 3, r0 = gc * 128;
    const int qb = wid & 3, eh = wid >> 2;
    ldsp bufA = lds, bufB = lds + 34816, bufC = lds + 75776; LAS float* ssx = (LAS float*)(lds + 116736);
    bf16x8 qf[8];
    { const bf16_t* qp = QU + (size_t)(r0 + 32 * qb + r32) * 1024 + 128 * h + 8 * hi;
#pragma unroll
      for (int s = 0; s < 8; ++s) qf[s] = *(const bf16x8*)(qp + 16 * s); }
#pragma unroll
    for (int i = 0; i < 4; ++i) {
        const int cidx = tid + 512 * i, key = cidx >> 4, ch = cidx & 15;
        *(LAS u32x4*)(bufA + key * 272 + ch * 16) = *(const u32x4*)(K0 + (size_t)(r0 + key) * 512 + 128 * h + 8 * ch);
        *(LAS u32x4*)(bufB + key * 320 + ch * 16) = *(const u32x4*)(KV + (size_t)(uidx * 2 + 0) * 16384 + key * 128 + 8 * ch);
        *(LAS u32x4*)(bufC + key * 320 + ch * 16) = *(const u32x4*)(KV + (size_t)(uidx * 2 + 1) * 16384 + key * 128 + 8 * ch);
    }
    __syncthreads();
    const int trow = (lane & 15) >> 2, tcol = 16 * ((lane >> 4) & 1) + 4 * (lane & 3);
    f32x16 ot[2];
    {
        f32x16 af[2], ab[2];
#pragma unroll
        for (int e2 = 0; e2 < 2; ++e2)
#pragma unroll
            for (int r = 0; r < 16; ++r) { af[e2][r] = 0.f; ab[e2][r] = 0.f; }
#pragma unroll
        for (int s = 0; s < 8; ++s) {
            const int drow = 16 * s + 8 * hi + trow;
#pragma unroll
            for (int e2 = 0; e2 < 2; ++e2) {
                const int eb = 2 * eh + e2;
                const bf16x8 f1 = tr_frag(bufB + drow * 320 + (32 * eb + tcol) * 2, 4 * 320);
                af[e2] = mfma32(qf[s], f1, af[e2]);
                const bf16x8 f2 = tr_frag(bufC + drow * 320 + (32 * eb + tcol) * 2, 4 * 320);
                ab[e2] = mfma32(qf[s], f2, ab[e2]);
            }
        }
#pragma unroll
        for (int r = 0; r < 16; ++r) {
            const int irow = 32 * qb + crow(r, hi);
            const float sf = ex2(lgf2 * (float)(irow + 1)), sb = ex2(lgb2 * (float)(128 - irow));
#pragma unroll
            for (int e2 = 0; e2 < 2; ++e2) ot[e2][r] = af[e2][r] * sf + ab[e2][r] * sb;
        }
    }
    __syncthreads();
#pragma unroll
    for (int i = 0; i < 4; ++i) {
        const int cidx = tid + 512 * i, key = cidx >> 4, ch = cidx & 15;
        *(LAS u32x4*)(bufB + key * 320 + ch * 16) = *(const u32x4*)(V0 + (size_t)(r0 + key) * 512 + 128 * h + 8 * ch);
    }
    __syncthreads();
    {
        f32x16 p[4];
#pragma unroll
        for (int kb = 0; kb < 4; ++kb)
#pragma unroll
            for (int r = 0; r < 16; ++r) p[kb][r] = 0.f;
#pragma unroll
        for (int s = 0; s < 8; ++s)
#pragma unroll
            for (int kb = 0; kb < 4; ++kb) {
                const bf16x8 a = *(const LAS bf16x8*)(bufA + (32 * kb + r32) * 272 + (16 * s + 8 * hi) * 2);
                p[kb] = mfma32(a, qf[s], p[kb]);
            }
        const int iq = 32 * qb + r32;
        bf16x8 pa[8];
#pragma unroll
        for (int kb = 0; kb < 4; ++kb) {
#pragma unroll
            for (int r = 0; r < 16; ++r) {
                const int j = 32 * kb + crow(r, hi), dl = iq - j;
                const float wgt = dl >= 0 ? ex2(lgf2 * (float)dl) : ex2(lgb2 * (float)(-dl));
                p[kb][r] *= wgt;
            }
            pa[2 * kb] = pack8(p[kb][0], p[kb][1], p[kb][2], p[kb][3], p[kb][4], p[kb][5], p[kb][6], p[kb][7]);
            pa[2 * kb + 1] = pack8(p[kb][8], p[kb][9], p[kb][10], p[kb][11], p[kb][12], p[kb][13], p[kb][14], p[kb][15]);
        }
#pragma unroll
        for (int ks = 0; ks < 8; ++ks) {
            const int vrow = 16 * ks + 4 * hi + trow;
#pragma unroll
            for (int e2 = 0; e2 < 2; ++e2) {
                const int eb = 2 * eh + e2;
                const bf16x8 vf = tr_frag(bufB + vrow * 320 + (32 * eb + tcol) * 2, 8 * 320);
                ot[e2] = mfma32(pa[ks], vf, ot[e2]);
            }
        }
    }
#pragma unroll
    for (int r = 0; r < 16; ++r) {
        float ss = ot[0][r] * ot[0][r] + ot[1][r] * ot[1][r];
        ss = sum32(ss);
        if (r32 == 0) ssx[(qb * 32 + crow(r, hi)) * 2 + eh] = ss;
    }
    __syncthreads();
    ldsp st = lds + wid * 8704;
    const float rg0 = retg[128 * h + 64 * eh + r32], rg1 = retg[128 * h + 64 * eh + 32 + r32];
#pragma unroll
    for (int r = 0; r < 16; ++r) {
        const int lr = qb * 32 + crow(r, hi);
        const float rstd = __builtin_amdgcn_rsqf((ssx[lr * 2] + ssx[lr * 2 + 1]) * (1.f / 128.f) + EPS);
        LAS float* sp = (LAS float*)(st + crow(r, hi) * 272) + r32;
        sp[0] = ot[0][r] * rstd * rg0; sp[32] = ot[1][r] * rstd * rg1;
    }
    asm volatile("s_waitcnt lgkmcnt(0)" ::: "memory");
#pragma unroll
    for (int i = 0; i < 4; ++i) {
        const int idx = lane + 64 * i, row = idx >> 3, ch = idx & 7;
        const f32x4 a = *(const LAS f32x4*)(st + row * 272 + ch * 32), b = *(const LAS f32x4*)(st + row * 272 + ch * 32 + 16);
        const size_t grow = (size_t)(r0 + qb * 32 + row); const int col = 128 * h + 64 * eh + 8 * ch;
        const u32x4 g = *(const u32x4*)(SG + grow * 512 + col);
        u32x4 w; w.x = cvt_pk_bf16(a[0] * bflo(g.x), a[1] * bfhi(g.x)); w.y = cvt_pk_bf16(a[2] * bflo(g.y), a[3] * bfhi(g.y));
        w.z = cvt_pk_bf16(b[0] * bflo(g.z), b[1] * bfhi(g.z)); w.w = cvt_pk_bf16(b[2] * bflo(g.w), b[3] * bfhi(g.w));
        *(u32x4*)(QU + grow * 1024 + col) = w;
    }
    __syncthreads();
}

__device__ __forceinline__ float shx(float v, int lane, int o) { return __builtin_bit_cast(float, __builtin_amdgcn_ds_bpermute((lane ^ o) << 2, __builtin_bit_cast(int, v))); }
__device__ __forceinline__ void glds16(const void* gsrc, unsigned lds_dst) { unsigned keep;
    asm volatile("s_mov_b32 %0, m0\n\ts_mov_b32 m0, %2\n\ts_nop 0\n\tglobal_load_lds_dwordx4 %1, off\n\ts_mov_b32 m0, %0" : "=&s"(keep) : "v"(gsrc), "s"(lds_dst) : "memory"); }
__device__ __forceinline__ unsigned dma_off(int y, int P) { const int row = y / P, cw = y - P * row; return (unsigned)(row * 1024 + (cw < 16 ? cw : 15) * 8) * 2u; }
__device__ __forceinline__ void glds16s(const void* gbase, unsigned voff, unsigned lds_dst) { unsigned keep;
    asm volatile("s_mov_b32 %0, m0\n\ts_mov_b32 m0, %3\n\ts_nop 0\n\tglobal_load_lds_dwordx4 %1, %2\n\ts_mov_b32 m0, %0" : "=&s"(keep) : "v"(voff), "s"(gbase), "s"(lds_dst) : "memory"); }
#define ATTN_DMA(KOFS, VOFS, KT_BASE, VT_BASE) do { \
        const unsigned l0_ = (unsigned)(uintptr_t)lds + 1024u * (unsigned)wid; \
        glds16s(KT_BASE, dk0, l0_ + (KOFS)); glds16s(KT_BASE, dk1, l0_ + (KOFS) + 8192u); if (wid == 0) glds16s(KT_BASE, dk2, l0_ + (KOFS) + 16384u); \
        glds16s(VT_BASE, dv0, l0_ + (VOFS)); glds16s(VT_BASE, dv1, l0_ + (VOFS) + 8192u); if (wid < 4) glds16s(VT_BASE, dv2, l0_ + (VOFS) + 16384u); } while (0)
__device__ __forceinline__ void attn_phase(ldsp lds, const bf16_t* Q1, const bf16_t* K1, const bf16_t* V1, bf16_t* O,
                                           const float* lamp, const float* subg, int vcu) {
    const int wid = __builtin_amdgcn_readfirstlane(otid() >> 6);
    float lam_full;
    { const int lane = otid() & 63; const float la = wave_sum(lamp[lane] * lamp[64 + lane]), lb = wave_sum(lamp[128 + lane] * lamp[192 + lane]);
      lam_full = __builtin_bit_cast(float, __builtin_amdgcn_readfirstlane(__builtin_bit_cast(int, expf(la) - expf(lb) + LINIT1))); }
    for (int ui = 0; ui < 4; ++ui) {
        const int u = vcu + 256 * (ui & 1);
        int S, row0, head, qb;
        if (ui < 2) { S = 4096; row0 = (u >> 7) * 4096; head = (u >> 4) & 7; qb = u & 15; }
        else { S = 8192; row0 = NPROMPT + (u >> 8) * 8192; head = (u >> 5) & 7; qb = u & 31; }
        const int NT = S / 64;
        const int qrow0 = row0 + qb * 256 + wid * 32;
        ldsp Qw = lds + 77824 + wid * 8704;
        { const int lane = otid() & 63;
#pragma unroll
          for (int i = 0; i < 8; ++i) { const int idx = lane + 64 * i, row = idx >> 4, ch = idx & 15;
              *(LAS u32x4*)(Qw + row * 272 + ch * 16) = *(const u32x4*)(Q1 + (size_t)(qrow0 + row) * 1024 + 128 * head + 8 * ch); } }
        const bf16_t* kbase = K1 + (size_t)row0 * 1024 + 128 * head; const bf16_t* vbase = V1 + (size_t)row0 * 1024 + 128 * head;
        f32x16 o[2][4];
#pragma unroll
        for (int c = 0; c < 2; ++c)
#pragma unroll
            for (int eb = 0; eb < 4; ++eb)
#pragma unroll
                for (int r = 0; r < 16; ++r) o[c][eb][r] = 0.f;
        float l0 = 0.f, l1 = 0.f;
        unsigned dk0, dk1, dk2, dv0, dv1, dv2;
        { const int lane = otid() & 63; dk0 = dma_off(64 * wid + lane, 17); dk1 = dma_off(64 * (wid + 8) + lane, 17); dk2 = dma_off(64 * 16 + lane, 17);
          dv0 = dma_off(64 * wid + lane, 20); dv1 = dma_off(64 * (wid + 8) + lane, 20); dv2 = dma_off(64 * (wid + 16) + lane, 20); }
        ATTN_DMA(0u, 34816u, kbase, vbase);
        asm volatile("s_waitcnt vmcnt(0)" ::: "memory");
        __syncthreads();
        for (int kt = 0; kt < NT; ++kt) {
            const int cur = kt & 1;
            const bool more = (kt + 1 < NT);
            const int tid = otid(), lane = tid & 63, r32 = lane & 31, hi = lane >> 5;
            const int trow = (lane & 15) >> 2, tcol = 16 * ((lane >> 4) & 1) + 4 * (lane & 3);
            ldsp Kb = lds + cur * 17408 + r32 * 272 + 16 * hi, Vb = lds + 34816 + cur * 20480 + (4 * hi + trow) * 320 + tcol * 2;
            ldsp qrd = Qw + r32 * 272 + 16 * hi;
            if (more) ATTN_DMA((unsigned)(cur ^ 1) * 17408u, 34816u + (unsigned)(cur ^ 1) * 20480u, kbase + (size_t)(kt + 1) * 64 * 1024, vbase + (size_t)(kt + 1) * 64 * 1024);
#define SBAR_ __builtin_amdgcn_sched_barrier(0)
#define SQL(C, S) do { kf0[S] = *(const LAS bf16x8*)(Kb + (64 * (C) + 16 * (S)) * 2); kf1[S] = *(const LAS bf16x8*)(Kb + 32 * 272 + (64 * (C) + 16 * (S)) * 2); \
        qfv[S] = *(const LAS bf16x8*)(qrd + (64 * (C) + 16 * (S)) * 2); } while (0)
#define SQM(S, P0, P1) do { __builtin_amdgcn_s_setprio(1); P0 = mfma32(kf0[S], qfv[S], P0); P1 = mfma32(kf1[S], qfv[S], P1); __builtin_amdgcn_s_setprio(0); } while (0)
#define SQT(C, P0, P1, HOOK) do { _Pragma("unroll") for (int r = 0; r < 16; ++r) { P0[r] = 0.f; P1[r] = 0.f; } \
        SQL(C, 1); SBAR_; SQM(0, P0, P1); SQL(C, 2); SBAR_; SQM(1, P0, P1); SQL(C, 3); SBAR_; SQM(2, P0, P1); HOOK; SBAR_; SQM(3, P0, P1); SBAR_; } while (0)
#define VFL2(VF, KS, H) do { VF[2 * (H)] = tr_frag(Vb + 16 * (KS) * 320 + 64 * (2 * (H)), 8 * 320); VF[2 * (H) + 1] = tr_frag(Vb + 16 * (KS) * 320 + 64 * (2 * (H) + 1), 8 * 320); } while (0)
#define VFL(VF, KS) do { VFL2(VF, KS, 0); VFL2(VF, KS, 1); } while (0)
#define VWORK(P, B, G, W, RS) do { const float e0_ = ex2(P[(B) + 2 * (G)]), e1_ = ex2(P[(B) + 2 * (G) + 1]); RS += e0_ + e1_; W[G] = cvt_pk_bf16(e0_, e1_); } while (0)
#define GRP(OC, WCUR, VFCUR, VFNEXT, KSNEXT, P, B, WNEXT, RS, PRE) do { __builtin_amdgcn_s_setprio(1); \
        OC[0] = mfma32(__builtin_bit_cast(bf16x8, WCUR), VFCUR[0], OC[0]); if (PRE) VFL2(VFNEXT, KSNEXT, 0); VWORK(P, B, 0, WNEXT, RS); SBAR_; \
        OC[1] = mfma32(__builtin_bit_cast(bf16x8, WCUR), VFCUR[1], OC[1]); VWORK(P, B, 1, WNEXT, RS); SBAR_; \
        OC[2] = mfma32(__builtin_bit_cast(bf16x8, WCUR), VFCUR[2], OC[2]); if (PRE) VFL2(VFNEXT, KSNEXT, 1); VWORK(P, B, 2, WNEXT, RS); SBAR_; \
        OC[3] = mfma32(__builtin_bit_cast(bf16x8, WCUR), VFCUR[3], OC[3]); VWORK(P, B, 3, WNEXT, RS); __builtin_amdgcn_s_setprio(0); SBAR_; } while (0)
            {
                f32x16 pA0, pA1, pB0, pB1; u32x4 wA, wB; bf16x8 vfA[4], vfB[4], kf0[4], kf1[4], qfv[4];
                SQL(0, 0); SBAR_;
                SQT(0, pA0, pA1, (void)0);
                VFL(vfA, 0);
                VWORK(pA0, 0, 0, wA, l0); VWORK(pA0, 0, 1, wA, l0); VWORK(pA0, 0, 2, wA, l0); VWORK(pA0, 0, 3, wA, l0); SBAR_;
                GRP(o[0], wA, vfA, vfB, 1, pA0, 8, wB, l0, true);
                GRP(o[0], wB, vfB, vfA, 2, pA1, 0, wA, l0, true);
                GRP(o[0], wA, vfA, vfB, 3, pA1, 8, wB, l0, false);
                SQL(1, 0); SBAR_;
                SQT(1, pB0, pB1, VFL(vfB, 3));
                GRP(o[0], wB, vfB, vfA, 0, pB0, 0, wA, l1, true);
                GRP(o[1], wA, vfA, vfB, 1, pB0, 8, wB, l1, true);
                GRP(o[1], wB, vfB, vfA, 2, pB1, 0, wA, l1, true);
                GRP(o[1], wA, vfA, vfB, 3, pB1, 8, wB, l1, true);
#pragma unroll
                for (int eb = 0; eb < 4; ++eb) o[1][eb] = mfma32(__builtin_bit_cast(bf16x8, wB), vfB[eb], o[1][eb]);
                SBAR_;
            }
#undef SQT
#undef SQL
#undef SQM
#undef VFL
#undef VWORK
#undef GRP
#undef SBAR_
            asm volatile("s_waitcnt vmcnt(0)" ::: "memory");
            __syncthreads();
        }
        {
            const int lane = otid() & 63, r32 = lane & 31, hi = lane >> 5;
            LAS float* lsc = (LAS float*)(lds + 75776) + wid * 64;
            l0 += shx(l0, lane, 32); l1 += shx(l1, lane, 32);
            if (hi == 0) { lsc[r32] = l0; lsc[32 + r32] = l1; }
            asm volatile("s_waitcnt lgkmcnt(0)" ::: "memory");
            const float g0 = subg[r32], g1 = subg[32 + r32], g2 = subg[64 + r32], g3 = subg[96 + r32];
#pragma unroll
            for (int r = 0; r < 16; ++r) {
                const int lr = crow(r, hi);
                const float i0 = __builtin_amdgcn_rcpf(lsc[lr]), i1 = lam_full * __builtin_amdgcn_rcpf(lsc[32 + lr]);
                const float v0 = o[0][0][r] * i0 - o[1][0][r] * i1, v1 = o[0][1][r] * i0 - o[1][1][r] * i1;
                const float v2 = o[0][2][r] * i0 - o[1][2][r] * i1, v3 = o[0][3][r] * i0 - o[1][3][r] * i1;
                float ss = (v0 * v0 + v1 * v1) + (v2 * v2 + v3 * v3);
                ss += shx(ss, lane, 1); ss += shx(ss, lane, 2); ss += shx(ss, lane, 4); ss += shx(ss, lane, 8); ss += shx(ss, lane, 16);
                const float rstd = __builtin_amdgcn_rsqf(ss * (1.f / 128.f) + EPS) * (1.f - LINIT1);
                LAS unsigned short* sp = (LAS unsigned short*)(Qw + lr * 272) + r32;
                sp[0] = f2bf(v0 * rstd * g0); sp[32] = f2bf(v1 * rstd * g1); sp[64] = f2bf(v2 * rstd * g2); sp[96] = f2bf(v3 * rstd * g3);
            }
            asm volatile("s_waitcnt lgkmcnt(0)" ::: "memory");
#pragma unroll
            for (int i = 0; i < 8; ++i) { const int idx = lane + 64 * i, row = idx >> 4, ch = idx & 15;
                *(u32x4*)(O + (size_t)(qrow0 + row) * 1024 + 128 * head + 8 * ch) = *(const LAS u32x4*)(Qw + row * 272 + ch * 16); }
            asm volatile("s_waitcnt lgkmcnt(0)" ::: "memory");
        }
    }
}

struct Args { const float* in[18]; float* out; unsigned char* ws; int ph_lo, ph_hi; };
constexpr int N_PHASES = 17;

template <class Epi>
__device__ __forceinline__ void run_gemm(ldsp lds, const bf16_t* A, const bf16_t* Bt, int N, int K, const Epi& E) {
    pg8::Gemm g{A, Bt, M, N, K}; pg8::StaticOrder S; S.init(M, N, 256, obx());
#ifndef NO_GEMM
    pg8::gemm_phase<Epi, pg8::StaticOrder, true, true>(lds, g, S, E);
#endif
}
#define WSP(off) ((bf16_t*)(a.ws + (off)))
#define SSP(k) ((unsigned long long*)(a.ws + WS_SS) + (size_t)(k) * M)
__device__ __forceinline__ void ph_prologue(const Args& a, ldsp lds) {
    const int tid = otid(), lane = tid & 63, wid = __builtin_amdgcn_readfirstlane(tid >> 6), bx = obx(), gw = bx * 8 + wid;
    LAS float* scr = (LAS float*)(lds + wid * 16384);
    constexpr int I_FFI = 16 * 176, I_FFO = 44 * 32, I_IN = 16 * 96, I_OUT = 16 * 32;
    constexpr int NITEMS = 4 * I_FFI + 4 * I_FFO + 2 * I_IN + 2 * I_OUT;
    const float* ng = a.in[2];
    for (int it = gw; it < NITEMS; it += 2048) {
        int r = it;
        if (r < 4 * I_FFI) { const int mi = r / I_FFI; const int gi = (mi >> 1) * 3 + ((mi & 1) ? 2 : 0);
            transpose_item(a.in[3] + (size_t)mi * 1024 * 5632, 1024, 5632, 1, WSP(WS_FFI + mi * W_FFI), scr, r % I_FFI, lane, ng + gi * D); continue; } r -= 4 * I_FFI;
        if (r < 4 * I_FFO) { const int mi = r / I_FFO; transpose_item(a.in[4] + (size_t)mi * 2816 * 1024, 2816, 1024, 0, WSP(WS_FFO + mi * W_FFO), scr, r % I_FFO, lane, nullptr); continue; } r -= 4 * I_FFO;
        if (r < I_IN) { transpose_item(a.in[5], 1024, 3072, 2, WSP(WS_ABI), scr, r, lane, ng + 1 * D); continue; } r -= I_IN;
        if (r < I_IN) { transpose_item(a.in[12], 1024, 3072, 3, WSP(WS_CI), scr, r, lane, ng + 4 * D); continue; } r -= I_IN;
        if (r < I_OUT) { transpose_item(a.in[11], 1024, 1024, 0, WSP(WS_ABO), scr, r, lane, nullptr); continue; } r -= I_OUT;
        transpose_item(a.in[17], 1024, 1024, 0, WSP(WS_CO), scr, r, lane, nullptr);
    }
    float* tab0 = (float*)(a.ws + WS_TAB0); float* tab1 = (float*)(a.ws + WS_TAB1);
    for (int e = bx * 512 + tid; e < 8192 * 96; e += 256 * 512) { if (e < 8192 * 64) rope_entry(tab0, 64, e); else rope_entry(tab1, 32, e - 8192 * 64); }
    for (int e = bx * 512 + tid; e < 5 * M; e += 256 * 512) SSP(1)[e] = 0ull;
    norm_phase(a.in[0], a.in[1], SSP(0), WSP(WS_XN), gw, lane);
}
__device__ __forceinline__ void ph_ffn_in(const Args& a, ldsp lds, int wi, int k) { run_gemm(lds, WSP(WS_XN), WSP(WS_FFI + (size_t)wi * W_FFI), 5632, 1024, EpiSwiglu{WSP(WS_H), SSP(k)}); }
template <int MODE>
__device__ __forceinline__ void ph_ffn_out(const Args& a, ldsp lds, int wi, int k) {
    run_gemm(lds, WSP(WS_H), WSP(WS_FFO + (size_t)wi * W_FFO), 1024, 2816, EpiResid<MODE>{a.in[0], a.in[1], a.out, 0.5f, WSP(WS_XN), SSP(k)});
}
__device__ __forceinline__ void ph_outproj(const Args& a, ldsp lds, size_t aoff, size_t woff, int k) {
    run_gemm(lds, WSP(aoff), WSP(woff), 1024, 1024, EpiResid<1>{a.in[0], a.in[1], a.out, 1.0f, WSP(WS_XN), SSP(k)});
}

__global__ void __launch_bounds__(512, 2) fwd_kernel(Args a_in) {
    extern __shared__ __attribute__((aligned(16))) unsigned char lds_raw[];
    cg::grid_group grid = cg::this_grid();
    ldsp lds = (ldsp)lds_raw;
    const Args& a0 = a_in;
    if (threadIdx.x < 16) ((LAS unsigned*)(lds + LDS_MISC))[threadIdx.x] = 0u;
    __syncthreads();
    XcdBarrier bar = xcd_barrier_post((unsigned*)(a_in.ws + WS_CTL), (volatile LAS unsigned*)(lds + LDS_MISC));
    for (int ph = a0.ph_lo; ph < a0.ph_hi; ++ph) {
        Args a = a0; asm volatile("" : "+s"(a.ws), "+s"(a.out));
        switch (ph) {
        case 0: ph_prologue(a, lds); break;
        case 1: ph_ffn_in(a, lds, 0, 0); break;
        case 2: ph_ffn_out<0>(a, lds, 0, 1); break;
        case 3:
            run_gemm(lds, WSP(WS_XN), WSP(WS_ABI), 3072, 1024, EpiABAll{WSP(WS_QU), WSP(WS_K0), WSP(WS_V0), WSP(WS_SG), WSP(WS_U), (const float*)(a.ws + WS_TAB0), SSP(1)});
            break;
        case 4: {
            const int bx = obx(); const float lgf2 = -expf(a.in[6][(bx & 3)]) * LOG2E, lgb2 = -expf(a.in[6][4 + (bx & 3)]) * LOG2E;
            for (int i = 0; i < 4; ++i) r1_unit(lds, bx + 256 * i, WSP(WS_K0), WSP(WS_V0), (bf16_t*)a.out, lgf2, lgb2);
            for (int i = 0; i < 4; ++i) conv_tile(lds, bx + 256 * i, WSP(WS_U), a.in[8], a.in[9], a.in[10], WSP(WS_QU));
        } break;
        case 5: scan_phase((bf16_t*)a.out, a.in[6], obx() * 512 + otid()); break;
        case 6: {
            const int bx = obx(); const float lgf2 = -expf(a.in[6][(bx & 3)]) * LOG2E, lgb2 = -expf(a.in[6][4 + (bx & 3)]) * LOG2E;
            for (int i = 0; i < 4; ++i) r3_unit(lds, bx + 256 * i, WSP(WS_QU), WSP(WS_K0), WSP(WS_V0), WSP(WS_SG), (bf16_t*)a.out, a.in[7], lgf2, lgb2);
        } break;
        case 7: ph_outproj(a, lds, WS_QU, WS_ABO, 2); break;
        case 8: ph_ffn_in(a, lds, 1, 2); break;
        case 9: ph_ffn_out<1>(a, lds, 1, 3); break;
        case 10: ph_ffn_in(a, lds, 2, 3); break;
        case 11: ph_ffn_out<1>(a, lds, 2, 4); break;
        case 12: run_gemm(lds, WSP(WS_XN), WSP(WS_CI), 3072, 1024, EpiC{WSP(WS_Q1), WSP(WS_K1), WSP(WS_V1), (const float*)(a.ws + WS_TAB1), a.in[13], a.in[14], SSP(4)}); break;
        case 13: {
            const int bx = obx(); const int vcu = (bx % 8) * 32 + bx / 8;
            attn_phase(lds, WSP(WS_Q1), WSP(WS_K1), WSP(WS_V1), WSP(WS_Q1), a.in[15], a.in[16], vcu);
        } break;
        case 14: ph_outproj(a, lds, WS_Q1, WS_CO, 5); break;
        case 15: ph_ffn_in(a, lds, 3, 5); break;
        case 16: ph_ffn_out<2>(a, lds, 3, 0); break;
        default: break;
        }
        if (ph + 1 < a0.ph_hi) { if (a0.ph_hi > 1000) grid.sync(); else xcd_barrier(bar); }
    }
}
}

extern "C" void kernel_launch(void* const* d_in, const int* in_sizes, int n_in, void* d_out, int out_size, void* d_ws, size_t ws_size, hipStream_t stream) {
    static int grid = 0;
    if (grid == 0) {
        if (n_in != 18 || out_size != mk::M * mk::D || ws_size < mk::WS_END) { fprintf(stderr, "kernel_launch: unexpected shapes n_in %d out %d ws %zu\n", n_in, out_size, ws_size); grid = -1; return; }
        int dev = 0, cus = 0, per_cu = 0;
        (void)hipGetDevice(&dev); (void)hipDeviceGetAttribute(&cus, hipDeviceAttributeMultiprocessorCount, dev);
        (void)hipFuncSetAttribute((const void*)mk::fwd_kernel, hipFuncAttributeMaxDynamicSharedMemorySize, mk::LDS_BYTES);
        (void)hipOccupancyMaxActiveBlocksPerMultiprocessor(&per_cu, (const void*)mk::fwd_kernel, 512, mk::LDS_BYTES);
        (void)hipGetLastError();
        grid = cus > 0 ? cus : 256;
        if (grid > 256) grid = 256;
    }
    if (grid < 0) return;
    mk::Args a{};
    for (int i = 0; i < 18; ++i) a.in[i] = (const float*)d_in[i];
    a.out = (float*)d_out; a.ws = (unsigned char*)d_ws; a.ph_lo = 0; a.ph_hi = mk::N_PHASES;
    (void)hipMemsetAsync((char*)d_ws + mk::WS_CTL, 0, mk::CTL_BYTES, stream);
    void* args[] = {&a};
    hipError_t e = hipLaunchCooperativeKernel((const void*)mk::fwd_kernel, dim3(grid), dim3(512), args, mk::LDS_BYTES, stream);
    if (e != hipSuccess) fprintf(stderr, "cooperative launch failed: %s (grid %d)\n", hipGetErrorString(e), grid);
}
```
